# Optimizing an MI355X kernel written in HIP

```python
import math
import jax, jax.numpy as jnp
from jax import lax
import numpy as np

D_MODEL = 2048
BATCH = 4
SEQ = 2048
DEPTH = 4

HEAD_DIM_A = 128
N_HEADS_A = D_MODEL // (2 * HEAD_DIM_A)
WIDTH_A = N_HEADS_A * HEAD_DIM_A
CONV_K = 5
CHUNK = 64
WIDTH_B = D_MODEL // 2
S5_GROUP_CH = 16
N_GROUPS_B = WIDTH_B // S5_GROUP_CH
S5_STATE = 64
DT_MIN = 0.001
DT_MAX = 0.1
RMS_EPS = 1e-6

COL_QKV = 3 * WIDTH_A
COL_ZA = WIDTH_A
COL_BETA = 2 * N_HEADS_A
COL_ALPHA = 2 * N_HEADS_A
COL_U = WIDTH_B
COL_ZB = WIDTH_B
COL_GATES = 2 * D_MODEL
PROJ_WIDTH = COL_QKV + COL_ZA + COL_BETA + COL_ALPHA + COL_U + COL_ZB + COL_GATES
SPLIT_POINTS = list(np.cumsum([COL_QKV, COL_ZA, COL_BETA, COL_ALPHA, COL_U, COL_ZB]).tolist())

kernel_name = "hybrid_gdn_s5_bidir_encoder"


def rmsnorm(x, g):
    xf = x.astype(jnp.float32)
    y = xf * lax.rsqrt(jnp.mean(xf * xf, axis=-1, keepdims=True) + RMS_EPS)
    return (y * g.astype(jnp.float32)).astype(x.dtype)


def l2norm(x):
    xf = x.astype(jnp.float32)
    return xf * lax.rsqrt(jnp.sum(xf * xf, axis=-1, keepdims=True) + RMS_EPS)


def centred_dwconv(x, w):
    pad = (CONV_K - 1) // 2
    L = x.shape[1]
    xp = jnp.pad(x, ((0, 0), (pad, pad), (0, 0)))
    return sum(xp[:, i:i + L] * w[i] for i in range(CONV_K))


def _to_chunks(t):
    b, l, h = t.shape[:3]
    t = t.reshape((b, l // CHUNK, CHUNK, h) + t.shape[3:])
    return jnp.moveaxis(jnp.moveaxis(t, 1, 0), 3, 2)


def gated_delta_chunked(q, k, v, g, beta):
    b_, l_, h_, dv = v.shape
    qc, kc, vc = _to_chunks(q), _to_chunks(k), _to_chunks(v)
    gc = jnp.cumsum(_to_chunks(g), axis=-1)
    bc = _to_chunks(beta)
    idx = jnp.arange(CHUNK)
    incl = idx[:, None] >= idx[None, :]
    strict = idx[:, None] > idx[None, :]
    decay = jnp.exp(jnp.where(incl, gc[..., :, None] - gc[..., None, :], -jnp.inf))
    kb = kc * bc[..., None]
    vb = vc * bc[..., None]
    lmat = jnp.where(strict, jnp.einsum('nbhck,nbhsk->nbhcs', kb, kc) * decay, 0.0)
    u = lax.linalg.triangular_solve(lmat, vb, left_side=True, lower=True, unit_diagonal=True)
    w = lax.linalg.triangular_solve(lmat, kb * jnp.exp(gc)[..., None], left_side=True, lower=True, unit_diagonal=True)
    qk = jnp.einsum('nbhck,nbhsk->nbhcs', qc, kc) * decay

    def step(S, xs):
        q_c, k_c, u_c, w_c, g_c, qk_c = xs
        v_new = u_c - jnp.einsum('bhck,bhkv->bhcv', w_c, S)
        o_c = (jnp.einsum('bhck,bhkv->bhcv', q_c * jnp.exp(g_c)[..., None], S)
               + jnp.einsum('bhcs,bhsv->bhcv', qk_c, v_new))
        g_last = g_c[..., -1:]
        S = (S * jnp.exp(g_last)[..., None]
             + jnp.einsum('bhck,bhcv->bhkv', k_c * jnp.exp(g_last - g_c)[..., None], v_new))
        return S, o_c

    s0 = jnp.zeros((b_, h_, q.shape[-1], dv), jnp.float32)
    _, o = lax.scan(step, s0, (qc, kc, u, w, gc, qk))
    o = jnp.moveaxis(jnp.moveaxis(o, 2, 3), 0, 1)
    return o.reshape(b_, l_, h_, dv)


def bidir_gated_delta(q, k, v, g, beta):
    flip = lambda t: jnp.flip(t, axis=1)
    fwd = gated_delta_chunked(q, k, v, g[:, :, 0], beta[:, :, 0])
    bwd = flip(gated_delta_chunked(flip(q), flip(k), flip(v), flip(g[:, :, 1]), flip(beta[:, :, 1])))
    return fwd + bwd


def _ssm_combine(left, right):
    a_i, b_i = left
    a_j, b_j = right
    return a_j * a_i, a_j * b_i + b_j


def s5_bidirectional(u, lam_re, lam_im, log_dt, b_re, b_im, c_re, c_im, d_skip):
    f32 = jnp.float32
    bsz, L, _ = u.shape
    ug = u.astype(f32).reshape(bsz, L, N_GROUPS_B, S5_GROUP_CH)
    ugc = ug.astype(jnp.complex64)
    lam = lax.complex(lam_re.astype(f32), lam_im.astype(f32))
    dt = jnp.exp(log_dt.astype(f32))[..., None]
    lam_bar = jnp.exp(lam * dt)
    b_bar = ((lam_bar - 1.0) / lam)[..., None] * lax.complex(b_re.astype(f32), b_im.astype(f32))
    c = lax.complex(c_re.astype(f32), c_im.astype(f32))

    def one_direction(d, reverse):
        bu = jnp.einsum('gpc,blgc->blgp', b_bar[d], ugc)
        a = jnp.broadcast_to(lam_bar[d], bu.shape)
        _, states = lax.associative_scan(_ssm_combine, (a, bu), axis=1, reverse=reverse)
        return jnp.einsum('gcp,blgp->blgc', c[d], states).real

    y = (one_direction(0, False) + one_direction(1, True)
         + ug * d_skip.astype(f32).reshape(N_GROUPS_B, S5_GROUP_CH))
    return y.reshape(bsz, L, WIDTH_B).astype(u.dtype)


def hybrid_layer(x, ln_g, w_in, conv_w, a_log, dt_bias, head_norm_g, lam_re, lam_im, log_dt,
                 b_re, b_im, c_re, c_im, d_skip, w_glu, b_glu, w_pa, w_pb, b_gate, w_out):
    bsz, L, _ = x.shape
    h = rmsnorm(x, ln_g)
    proj = h @ w_in
    qkv, z_a, beta_logit, alpha_logit, u, z_b, gate_logit = jnp.split(proj, SPLIT_POINTS, axis=-1)

    qkv = jax.nn.silu(centred_dwconv(qkv, conv_w))
    q, k, v = jnp.split(qkv, 3, axis=-1)
    q = l2norm(q.reshape(bsz, L, N_HEADS_A, HEAD_DIM_A)) * (HEAD_DIM_A ** -0.5)
    k = l2norm(k.reshape(bsz, L, N_HEADS_A, HEAD_DIM_A))
    v = v.reshape(bsz, L, N_HEADS_A, HEAD_DIM_A).astype(jnp.float32)
    beta = jax.nn.sigmoid(beta_logit.astype(jnp.float32).reshape(bsz, L, 2, N_HEADS_A))
    g = -jnp.exp(a_log.astype(jnp.float32)) * jax.nn.softplus(
        alpha_logit.astype(jnp.float32).reshape(bsz, L, 2, N_HEADS_A) + dt_bias.astype(jnp.float32))
    o_a = bidir_gated_delta(q, k, v, g, beta)
    o_a = rmsnorm(o_a, head_norm_g).reshape(bsz, L, WIDTH_A).astype(x.dtype)
    y_a = (o_a * jax.nn.silu(z_a)) @ w_pa

    y_s = jax.nn.gelu(s5_bidirectional(u, lam_re, lam_im, log_dt, b_re, b_im, c_re, c_im, d_skip))
    y_s = y_s * jax.nn.sigmoid(y_s @ w_glu + b_glu)
    y_b = (y_s * jax.nn.silu(z_b)) @ w_pb

    gate_a, gate_b = jnp.split(jax.nn.sigmoid(gate_logit + b_gate), 2, axis=-1)
    merged = gate_a * y_a + gate_b * y_b
    return x + merged @ w_out


def setup_inputs(seed: int = 0) -> dict:
    key = jax.random.key(seed)
    ks = jax.random.split(key, 24)
    f32 = jnp.float32
    nrm = lambda k, shape, scale: scale * jax.random.normal(k, shape, f32)
    x = jax.random.normal(ks[0], (BATCH, SEQ, D_MODEL), f32)
    ln_g = 1.0 + nrm(ks[1], (DEPTH, D_MODEL), 0.02)
    w_in = nrm(ks[2], (DEPTH, D_MODEL, PROJ_WIDTH), D_MODEL ** -0.5)
    conv_w = nrm(ks[3], (DEPTH, CONV_K, 3 * WIDTH_A), CONV_K ** -0.5)
    a_log = jnp.log(jax.random.uniform(ks[4], (DEPTH, 2, N_HEADS_A), f32, 1.0, 16.0))
    dt = jnp.exp(jax.random.uniform(ks[5], (DEPTH, 2, N_HEADS_A), f32, math.log(DT_MIN), math.log(DT_MAX)))
    dt_bias = dt + jnp.log(-jnp.expm1(-dt))
    head_norm_g = 1.0 + nrm(ks[6], (DEPTH, HEAD_DIM_A), 0.02)
    ssm_shape = (DEPTH, 2, N_GROUPS_B, S5_STATE)
    lam_re = -0.5 + nrm(ks[7], ssm_shape, 0.01)
    lam_im = jnp.pi * jnp.arange(S5_STATE, dtype=f32) + nrm(ks[8], ssm_shape, 0.01)
    log_dt = jax.random.uniform(ks[9], (DEPTH, 2, N_GROUPS_B), f32, math.log(DT_MIN), math.log(DT_MAX))
    b_shape = (DEPTH, 2, N_GROUPS_B, S5_STATE, S5_GROUP_CH)
    b_re = nrm(ks[10], b_shape, (2 * S5_GROUP_CH) ** -0.5)
    b_im = nrm(ks[11], b_shape, (2 * S5_GROUP_CH) ** -0.5)
    c_shape = (DEPTH, 2, N_GROUPS_B, S5_GROUP_CH, S5_STATE)
    c_re = nrm(ks[12], c_shape, (2 * S5_STATE) ** -0.5)
    c_im = nrm(ks[13], c_shape, (2 * S5_STATE) ** -0.5)
    d_skip = nrm(ks[14], (DEPTH, WIDTH_B), 1.0)
    w_glu = nrm(ks[15], (DEPTH, WIDTH_B, WIDTH_B), WIDTH_B ** -0.5)
    b_glu = nrm(ks[16], (DEPTH, WIDTH_B), 0.01)
    w_pa = nrm(ks[17], (DEPTH, WIDTH_A, D_MODEL), WIDTH_A ** -0.5)
    w_pb = nrm(ks[18], (DEPTH, WIDTH_B, D_MODEL), WIDTH_B ** -0.5)
    b_gate = nrm(ks[19], (DEPTH, 2 * D_MODEL), 0.01)
    w_out = nrm(ks[20], (DEPTH, D_MODEL, D_MODEL), D_MODEL ** -0.5)
    final_g = 1.0 + nrm(ks[21], (D_MODEL,), 0.02)
    return {"x": x, "ln_g": ln_g, "w_in": w_in, "conv_w": conv_w, "a_log": a_log,
            "dt_bias": dt_bias, "head_norm_g": head_norm_g, "lam_re": lam_re, "lam_im": lam_im,
            "log_dt": log_dt, "b_re": b_re, "b_im": b_im, "c_re": c_re, "c_im": c_im,
            "d_skip": d_skip, "w_glu": w_glu, "b_glu": b_glu, "w_pa": w_pa, "w_pb": w_pb,
            "b_gate": b_gate, "w_out": w_out, "final_g": final_g}


def reference(x, ln_g, w_in, conv_w, a_log, dt_bias, head_norm_g, lam_re, lam_im, log_dt,
              b_re, b_im, c_re, c_im, d_skip, w_glu, b_glu, w_pa, w_pb, b_gate, w_out, final_g):
    for l in range(DEPTH):
        x = hybrid_layer(x, ln_g[l], w_in[l], conv_w[l], a_log[l], dt_bias[l], head_norm_g[l],
                         lam_re[l], lam_im[l], log_dt[l], b_re[l], b_im[l], c_re[l], c_im[l],
                         d_skip[l], w_glu[l], b_glu[l], w_pa[l], w_pb[l], b_gate[l], w_out[l])
    return rmsnorm(x, final_g)
```

```cpp
#include <hip/hip_runtime.h>
#include <hip/hip_cooperative_groups.h>
#include <cstdio>
namespace cg = cooperative_groups;


#ifndef PM
#define PM 0xFFFF
#endif
#ifndef MULTI_LAUNCH
#define MULTI_LAUNCH 0
#endif

#define DI __device__ __forceinline__
#define LAS __attribute__((address_space(3)))
typedef unsigned short bf16_t;
typedef short bf16x8 __attribute__((ext_vector_type(8)));
typedef float f32x4 __attribute__((ext_vector_type(4)));
typedef float f32x16 __attribute__((ext_vector_type(16)));
typedef unsigned u32x4 __attribute__((ext_vector_type(4)));
typedef unsigned u32x2 __attribute__((ext_vector_type(2)));

__device__ __forceinline__ int ltid() { int t = __builtin_amdgcn_workitem_id_x(); asm volatile("" : "+v"(t)); return t; }
namespace pg8 {
#define PG8_LAS __attribute__((address_space(3)))
constexpr int BM = 256, BK = 64, HALF = 128, HTB = HALF * BK * 2  , STAGE_BYTES = 8 * HTB, NXCD = 8, WGM = 8;

__host__ __device__ __forceinline__ int lds_byte(int r, int c) { const int st = (r >> 4) * 2 + (c >> 5), rr = r & 15, cc = c & 31, ob = rr * 64 + cc * 2; return st * 1024 + (ob ^ (((ob >> 9) & 1) << 5)); }
__host__ __device__ __forceinline__ void stage_rc(int b, int& R, int& C) { const int st = b / 1024, sb = b % 1024, swz = sb ^ (((sb >> 9) & 1) << 5); R = (st >> 1) * 16 + swz / 64; C = (st & 1) * 32 + (swz % 64) / 2; }
__host__ __device__ __forceinline__ int perm32(int rho) { const int n = rho >> 4, i = rho & 15; return 8 * (i >> 2) + 4 * n + (i & 3); }

struct Unit { int pm, pn; };
struct Gemm { const bf16_t* A; const bf16_t* Bt; int lda, ldb, K; };

struct StaticOrder {
    int nM, nN, nwg, G, c;
    __host__ __device__ void init(int M, int N, int G_, int c_) { nM = M / BM; nN = N / BM; nwg = nM * nN; G = G_; c = c_; }
    __host__ __device__ bool next(int i, Unit& u) const {
        const long L = (long)i * G + c; if (L >= nwg) return false;
        int wgid = (int)L; { const int q = nwg / NXCD, r = nwg % NXCD, xcd = wgid % NXCD, off = wgid / NXCD; wgid = (xcd < r ? xcd * (q + 1) : r * (q + 1) + (xcd - r) * q) + off; }
        const int nig = WGM * nN, gid = wgid / nig, fm = gid * WGM, gsz = (nM - fm) < WGM ? (nM - fm) : WGM;
        u.pm = fm + ((wgid % nig) % gsz); u.pn = (wgid % nig) / gsz; return true;
    }
    __device__ __forceinline__ void a_ready(const Unit&) const {}
    __device__ __forceinline__ void done(const Unit&) const {}
};
struct ListOrder {
    int first, stride, count, mode;
    __device__ __forceinline__ bool next(int i, Unit& u) const { const int idx = first + i * stride; if (idx >= count) return false; if (mode == 0) { u.pm = idx; u.pn = idx; } else { u.pm = idx >> 1; u.pn = idx; } return true; }
    __device__ __forceinline__ void a_ready(const Unit&) const {}
    __device__ __forceinline__ void done(const Unit&) const {}
};
typedef __bf16 bf16x2_t __attribute__((ext_vector_type(2)));
typedef float f32x2_t __attribute__((ext_vector_type(2)));
__device__ __forceinline__ unsigned cvt_pk_bf16(float lo, float hi) { f32x2_t v = {lo, hi}; bf16x2_t b = __builtin_convertvector(v, bf16x2_t); return __builtin_bit_cast(unsigned, b); }

template <class Epi, class Sched>
__device__ __forceinline__ void gemm_phase(PG8_LAS unsigned char* lds, const Gemm g, const Sched& S, const Epi& E) {
    const int tid = ltid(), wid = __builtin_amdgcn_readfirstlane(tid >> 6), lane = tid & 63, wr = wid >> 2, wc = wid & 3, fr = lane & 15, fq = lane >> 4;
    const int K = g.K, nt = K / BK;
    unsigned voffA[2], voffB[2];
#pragma unroll
    for (int i = 0; i < 2; ++i) { int R, C; stage_rc(tid * 16 + i * 8192, R, C); const int Rb = Epi::PERM ? ((R & ~31) + perm32(R & 31)) : R;
        voffA[i] = (unsigned)(R * g.lda + C) * 2u; voffB[i] = (unsigned)(Rb * g.ldb + C) * 2u; }
    const size_t kstep = (size_t)(BK * 2);
    const size_t hstepA = (size_t)HALF * g.lda * 2, hstepB = (size_t)HALF * g.ldb * 2;
    const size_t tstepA = 2 * hstepA, tstepB = 2 * hstepB;
    const unsigned ldsw = (unsigned)wid * 1024u;
    const int aoff = lds_byte(wr * 64 + fr, fq * 8), boff = lds_byte(wc * 32 + fr, fq * 8);
#define PG8_SA(b, h) (((b) * 2 + (h)) * HTB)
#define PG8_SB(b, h) ((4 + (b) * 2 + (h)) * HTB)
#define PG8_STAGE(bufoff, gbase, voff) do { _Pragma("unroll") for (int _i = 0; _i < 2; ++_i) \
        __builtin_amdgcn_global_load_lds((const unsigned*)((const char*)(gbase) + (voff)[_i]), (PG8_LAS unsigned*)(lds + (bufoff) + ldsw + _i * 8192), 16, 0, 0); } while (0)
#define PG8_LDA(dst, b, h) do { _Pragma("unroll") for (int m = 0; m < 4; ++m) _Pragma("unroll") for (int k = 0; k < 2; ++k) dst[m][k] = *(const PG8_LAS bf16x8*)(lds + PG8_SA(b, h) + aoff + m * 2048 + k * 1024); } while (0)
#define PG8_LDB(dst, b, h) do { _Pragma("unroll") for (int n = 0; n < 2; ++n) _Pragma("unroll") for (int k = 0; k < 2; ++k) dst[n][k] = *(const PG8_LAS bf16x8*)(lds + PG8_SB(b, h) + boff + n * 2048 + k * 1024); } while (0)
#define PG8_MMA(ai, bj, At, Bt) do { __builtin_amdgcn_s_setprio(1); _Pragma("unroll") for (int m = 0; m < 4; ++m) _Pragma("unroll") for (int n = 0; n < 2; ++n) _Pragma("unroll") for (int k = 0; k < 2; ++k) \
        acc[ai][bj][m][n] = __builtin_amdgcn_mfma_f32_16x16x32_bf16(Bt[n][k], At[m][k], acc[ai][bj][m][n], 0, 0, 0); __builtin_amdgcn_s_setprio(0); } while (0)
#define PG8_WAIT_V(n) asm volatile("s_waitcnt vmcnt(" #n ")" ::: "memory")
#define PG8_WAIT_L(n) asm volatile("s_waitcnt lgkmcnt(" #n ")" ::: "memory")
#define PG8_BAR __builtin_amdgcn_s_barrier()
#define PG8_SCHED __builtin_amdgcn_sched_barrier(0)
    Unit cur, nxt; int ui = 0;
    if (!S.next(0, cur)) return;
    f32x4 acc[2][2][4][2];
#pragma unroll
    for (int a = 0; a < 2; ++a)
#pragma unroll
        for (int b = 0; b < 2; ++b)
#pragma unroll
            for (int m = 0; m < 4; ++m)
#pragma unroll
                for (int n = 0; n < 2; ++n) acc[a][b][m][n] = (f32x4){0.f, 0.f, 0.f, 0.f};
    bf16x8 At[4][2], B0[2][2], B1[2][2];
    const char* cA = (const char*)g.A + (size_t)cur.pm * tstepA; const char* cB = (const char*)g.Bt + (size_t)cur.pn * tstepB;
    S.a_ready(cur);
    PG8_STAGE(PG8_SB(0, 0), cB, voffB); PG8_STAGE(PG8_SB(0, 1), cB + hstepB, voffB); PG8_STAGE(PG8_SA(0, 0), cA, voffA); PG8_STAGE(PG8_SA(0, 1), cA + hstepA, voffA);
    if (wr == 1) PG8_BAR;
    PG8_WAIT_V(2); PG8_BAR;
    PG8_STAGE(PG8_SB(1, 0), cB + kstep, voffB); PG8_STAGE(PG8_SA(1, 0), cA + kstep, voffA); PG8_STAGE(PG8_SB(1, 1), cB + hstepB + kstep, voffB);
    PG8_WAIT_V(6); PG8_BAR;
    for (;;) {
        const bool has_next = S.next(ui + 1, nxt);
        const char* nA = has_next ? (const char*)g.A + (size_t)nxt.pm * tstepA : cA; const char* nB = has_next ? (const char*)g.Bt + (size_t)nxt.pn * tstepB : cB;
        for (int khalf = 0; khalf < (Epi::HAS_MID ? 2 : 1); ++khalf) {
        const int kt0 = (Epi::HAS_MID && khalf) ? nt / 2 : 0, kt1 = (Epi::HAS_MID && !khalf) ? nt / 2 : nt;
        if constexpr (Epi::HAS_MID) { if (khalf) E.mid(acc, cur, wr, wc, fr, fq); }
        for (int t = kt0; t < kt1; t += 2) {
            const bool last = (t == nt - 2);
            const char* a1 = cA + (size_t)(t + 1) * kstep;
            const char* a2 = last ? nA : cA + (size_t)(t + 2) * kstep; const char* b2 = last ? nB : cB + (size_t)(t + 2) * kstep;
            const char* a3 = a2 + kstep; const char* b3 = b2 + kstep;
            if (last && has_next) S.a_ready(nxt);
            PG8_LDB(B0, 0, 0); PG8_LDB(B1, 0, 1); PG8_SCHED; PG8_LDA(At, 0, 0); PG8_STAGE(PG8_SA(1, 1), a1 + hstepA, voffA);
            PG8_WAIT_V(8); PG8_WAIT_L(0); PG8_BAR; PG8_MMA(0, 0, At, B0); PG8_MMA(0, 1, At, B1); PG8_BAR; PG8_SCHED;
            PG8_LDA(At, 0, 1); PG8_STAGE(PG8_SB(0, 0), b2, voffB); PG8_STAGE(PG8_SB(0, 1), b2 + hstepB, voffB); PG8_STAGE(PG8_SA(0, 0), a2, voffA);
            PG8_WAIT_V(8); PG8_WAIT_L(0); PG8_BAR; PG8_MMA(1, 0, At, B0); PG8_MMA(1, 1, At, B1); PG8_BAR; PG8_SCHED;
            PG8_LDB(B0, 1, 0); PG8_LDB(B1, 1, 1); PG8_SCHED; PG8_LDA(At, 1, 0); PG8_STAGE(PG8_SA(0, 1), a2 + hstepA, voffA);
            PG8_WAIT_V(8); PG8_WAIT_L(0); PG8_BAR; PG8_MMA(0, 0, At, B0); PG8_MMA(0, 1, At, B1); PG8_BAR; PG8_SCHED;
            PG8_LDA(At, 1, 1); PG8_STAGE(PG8_SB(1, 0), b3, voffB); PG8_STAGE(PG8_SB(1, 1), b3 + hstepB, voffB); PG8_STAGE(PG8_SA(1, 0), a3, voffA);
            PG8_WAIT_V(8); PG8_WAIT_L(0); PG8_BAR; PG8_MMA(1, 0, At, B0); PG8_MMA(1, 1, At, B1); PG8_BAR; PG8_SCHED;
        }
        }
        if (wr == 0) PG8_BAR;
        E(acc, cur, wr, wc, fr, fq); S.done(cur);
        if (!has_next) break;
#pragma unroll
        for (int a = 0; a < 2; ++a)
#pragma unroll
            for (int b = 0; b < 2; ++b)
#pragma unroll
                for (int m = 0; m < 4; ++m)
#pragma unroll
                    for (int n = 0; n < 2; ++n) acc[a][b][m][n] = (f32x4){0.f, 0.f, 0.f, 0.f};
        cur = nxt; cA = nA; cB = nB; ++ui;
        if (wr == 1) PG8_BAR;
    }
    PG8_WAIT_V(0);
    PG8_BAR;
#undef PG8_SA
#undef PG8_SB
#undef PG8_STAGE
#undef PG8_LDA
#undef PG8_LDB
#undef PG8_MMA
#undef PG8_WAIT_V
#undef PG8_WAIT_L
#undef PG8_BAR
#undef PG8_SCHED
}
}

constexpr int DM = 2048, NB = 4, SEQ = 2048, MTOK = NB * SEQ, DEPTH = 4;
constexpr int NH = 8, HD = 128, WA = 1024, WB = 1024, NG = 64, NP = 64, PROJ = 10272, NMAIN = 10240;
constexpr int TS5 = 32;
constexpr int KY = 768, KE = 512;
constexpr float RMS_EPS = 1e-6f;
constexpr int NTHREADS = 512, NWAVES = 8;
constexpr int LDS_BYTES = 147456;

constexpr size_t MiB = 1u << 20;
constexpr size_t alignup(size_t x) { return (x + 255) & ~(size_t)255; }
constexpr size_t WS_CTL = 0;
constexpr size_t SZ_WIN = (size_t)NMAIN * DM * 2, SZ_WBA = (size_t)32 * DM * 2, SZ_WGLU = (size_t)WB * WB * 2, SZ_WPA = (size_t)DM * WA * 2, SZ_WPB = (size_t)DM * WB * 2, SZ_WOUT = (size_t)DM * DM * 2;
constexpr size_t SZ_BTE = (size_t)NG * 256 * KE * 2, SZ_BTY = (size_t)NG * 512 * KY * 2;
constexpr size_t WS_EGP = 65536;
constexpr size_t WS_WIN = 1 * MiB;
constexpr size_t WS_WBA = WS_WIN + DEPTH * SZ_WIN;
constexpr size_t WS_WGLU = WS_WBA + DEPTH * SZ_WBA;
constexpr size_t WS_WPA = WS_WGLU + DEPTH * SZ_WGLU;
constexpr size_t WS_WPB = WS_WPA + DEPTH * SZ_WPA;
constexpr size_t WS_WOUT = WS_WPB + DEPTH * SZ_WPB;
constexpr size_t WS_BTE = WS_WOUT + DEPTH * SZ_WOUT;
constexpr size_t WS_BTY = WS_BTE + DEPTH * SZ_BTE;
constexpr size_t WS_X = WS_BTY + DEPTH * SZ_BTY;
constexpr size_t WS_H = WS_X + (size_t)MTOK * DM * 4;
constexpr size_t WS_BA = WS_H + (size_t)MTOK * DM * 2;
constexpr size_t WS_PQKV = WS_BA + (size_t)MTOK * 32 * 4;
constexpr size_t WS_ZA = WS_PQKV + (size_t)MTOK * 3072 * 2;
constexpr size_t WS_AS5 = WS_ZA + (size_t)MTOK * 1024 * 2;
constexpr size_t WS_ZB = WS_AS5 + (size_t)NG * 256 * KY * 2;
constexpr size_t WS_GT = WS_ZB + (size_t)MTOK * 1024 * 2;
constexpr size_t WS_EBUF = WS_GT + (size_t)MTOK * 4096 * 2;
constexpr size_t WS_YS = WS_EBUF + (size_t)NG * 256 * 256 * 4;
constexpr size_t WS_EG = WS_YS + (size_t)MTOK * 1024 * 2;
constexpr size_t WS_OF = WS_EG + 65536;
constexpr size_t WS_AA = WS_OF + (size_t)2 * MTOK * 1024 * 4;
constexpr size_t WS_AB = WS_AA + (size_t)MTOK * 1024 * 2;
constexpr size_t REC_BYTES = 73728;
constexpr size_t WS_REC = WS_AB + (size_t)MTOK * 1024 * 2;
constexpr size_t WS_TMP = WS_REC;
constexpr size_t WS_MG = WS_REC + (size_t)MTOK * DM * 4;
constexpr size_t WS_END = WS_REC + (size_t)4096 * REC_BYTES;
static_assert((size_t)MTOK * DM * 6 <= (size_t)4096 * REC_BYTES, "overlay");

struct Args { const float* in[22]; float* out; unsigned char* ws; int lo, hi, flags, pad; };

DI float bf2f(unsigned short b) { return __uint_as_float(((unsigned)b) << 16); }
DI unsigned pk2(float lo, float hi) { return pg8::cvt_pk_bf16(lo, hi); }
DI float sigmoidf_(float x) { return __builtin_amdgcn_rcpf(1.0f + __expf(-x)); }
DI float siluf_(float x) { return x * __builtin_amdgcn_rcpf(1.0f + __expf(-x)); }
DI float geluf_(float x) { return x * __builtin_amdgcn_rcpf(1.0f + __expf(-1.5957691216057308f * (x + 0.044715f * x * x * x))); }
DI void unpack8(const u32x4 v, float (&f)[8]) {
    f[0] = __uint_as_float(v.x << 16); f[1] = __uint_as_float(v.x & 0xffff0000u); f[2] = __uint_as_float(v.y << 16); f[3] = __uint_as_float(v.y & 0xffff0000u);
    f[4] = __uint_as_float(v.z << 16); f[5] = __uint_as_float(v.z & 0xffff0000u); f[6] = __uint_as_float(v.w << 16); f[7] = __uint_as_float(v.w & 0xffff0000u); }
DI u32x4 pack8(const float (&f)[8]) { u32x4 w; w.x = pk2(f[0], f[1]); w.y = pk2(f[2], f[3]); w.z = pk2(f[4], f[5]); w.w = pk2(f[6], f[7]); return w; }
DI float wave_sum(float v) {
#pragma unroll
    for (int o = 1; o < 64; o <<= 1) v += __shfl_xor(v, o);
    return v; }
#define MFMA32(a, b, c) __builtin_amdgcn_mfma_f32_32x32x16_bf16((a), (b), (c), 0, 0, 0)
DI int crow(int reg, int h) { return (reg & 3) + 8 * (reg >> 2) + 4 * h; }
#define LDS_WAIT() asm volatile("s_waitcnt lgkmcnt(0)" ::: "memory")
#define LBAR() do { asm volatile("s_waitcnt lgkmcnt(0)" ::: "memory"); __builtin_amdgcn_s_barrier(); asm volatile("" ::: "memory"); } while (0)

using pg8::Unit;
struct EpiInProj {
    static constexpr bool PERM = true, HAS_MID = false;
    bf16_t *pqkv, *za, *as5, *zb, *gt; const float* bgate;
    DI void operator()(const f32x4 (&acc)[2][2][4][2], const Unit& u, int wr, int wc, int fr, int fq) const {
        const int row0 = u.pm * 256 + wr * 64 + fr, colt = u.pn * 256;
#pragma unroll
        for (int ai = 0; ai < 2; ++ai)
#pragma unroll
            for (int m = 0; m < 4; ++m) { const int row = row0 + ai * 128 + m * 16;
#pragma unroll
                for (int bj = 0; bj < 2; ++bj) { const int col = colt + bj * 128 + wc * 32 + 8 * fq;
                    f32x4 v0 = acc[ai][bj][m][0], v1 = acc[ai][bj][m][1]; bf16_t* dst;
                    if (colt < 3072) dst = pqkv + (size_t)row * 3072 + col;
                    else if (colt < 4096) dst = za + (size_t)row * 1024 + (col - 3072);
                    else if (colt < 5120) { const int ch = col - 4096, g = ch >> 4, cp = ch & 15, n = row >> 5, s = row & 31; dst = as5 + ((size_t)(g * 256 + n) * KY + s * 16 + cp); }
                    else if (colt < 6144) dst = zb + (size_t)row * 1024 + (col - 5120);
                    else { const int gc = col - 6144; const f32x4 b0 = *(const f32x4*)(bgate + gc), b1 = *(const f32x4*)(bgate + gc + 4);
#pragma unroll
                        for (int j = 0; j < 4; ++j) { v0[j] = sigmoidf_(v0[j] + b0[j]); v1[j] = sigmoidf_(v1[j] + b1[j]); }
                        dst = gt + (size_t)row * 4096 + gc; }
                    u32x4 w; w.x = pk2(v0[0], v0[1]); w.y = pk2(v0[2], v0[3]); w.z = pk2(v1[0], v1[1]); w.w = pk2(v1[2], v1[3]);
                    *(u32x4*)dst = w; } }
    }
};
struct EpiE {
    static constexpr bool PERM = false, HAS_MID = false;
    float* E;
    DI void operator()(const f32x4 (&acc)[2][2][4][2], const Unit& u, int wr, int wc, int fr, int fq) const {
        float* base = E + (size_t)u.pm * 256 * 256;
#pragma unroll
        for (int ai = 0; ai < 2; ++ai)
#pragma unroll
            for (int m = 0; m < 4; ++m) { float* rowp = base + (size_t)(ai * 128 + wr * 64 + m * 16 + fr) * 256 + wc * 32 + 4 * fq;
#pragma unroll
                for (int bj = 0; bj < 2; ++bj)
#pragma unroll
                    for (int n = 0; n < 2; ++n) *(f32x4*)(rowp + bj * 128 + n * 16) = acc[ai][bj][m][n]; }
    }
};
struct EpiY {
    static constexpr bool PERM = true, HAS_MID = false;
    bf16_t* ys;
    DI void operator()(const f32x4 (&acc)[2][2][4][2], const Unit& u, int wr, int wc, int fr, int fq) const {
        const int g = u.pm, nt = u.pn & 1;
#pragma unroll
        for (int ai = 0; ai < 2; ++ai)
#pragma unroll
            for (int m = 0; m < 4; ++m) { const int n = ai * 128 + wr * 64 + m * 16 + fr;
#pragma unroll
                for (int bj = 0; bj < 2; ++bj) { const int cc = nt * 256 + bj * 128 + wc * 32 + 8 * fq, t = cc >> 4, c = cc & 15;
                    const f32x4 v0 = acc[ai][bj][m][0], v1 = acc[ai][bj][m][1];
                    float f[8] = {geluf_(v0[0]), geluf_(v0[1]), geluf_(v0[2]), geluf_(v0[3]), geluf_(v1[0]), geluf_(v1[1]), geluf_(v1[2]), geluf_(v1[3])};
                    *(u32x4*)(ys + ((size_t)(n * TS5 + t) * 1024 + g * 16 + c)) = pack8(f); } }
    }
};
struct EpiGlu {
    static constexpr bool PERM = true, HAS_MID = false;
    const bf16_t *ys, *zb; const float* bglu; bf16_t* ab;
    DI void operator()(const f32x4 (&acc)[2][2][4][2], const Unit& u, int wr, int wc, int fr, int fq) const {
        const int row0 = u.pm * 256 + wr * 64 + fr, colb = u.pn * 256 + wc * 32 + 8 * fq;
        f32x4 bb[2][2];
#pragma unroll
        for (int bj = 0; bj < 2; ++bj) { bb[bj][0] = *(const f32x4*)(bglu + colb + bj * 128); bb[bj][1] = *(const f32x4*)(bglu + colb + bj * 128 + 4); }
#pragma unroll
        for (int ai = 0; ai < 2; ++ai)
#pragma unroll
          for (int mp = 0; mp < 2; ++mp) { u32x4 yv[2][2], zv[2][2];
#pragma unroll
            for (int mm = 0; mm < 2; ++mm)
#pragma unroll
                for (int bj = 0; bj < 2; ++bj) { const size_t off = (size_t)(row0 + ai * 128 + (mp * 2 + mm) * 16) * 1024 + colb + bj * 128; yv[mm][bj] = *(const u32x4*)(ys + off); zv[mm][bj] = *(const u32x4*)(zb + off); }
#pragma unroll
            for (int mm = 0; mm < 2; ++mm)
#pragma unroll
                for (int bj = 0; bj < 2; ++bj) { const int m = mp * 2 + mm; const size_t off = (size_t)(row0 + ai * 128 + m * 16) * 1024 + colb + bj * 128;
                    const f32x4 v0 = acc[ai][bj][m][0], v1 = acc[ai][bj][m][1]; float y[8], z[8], o[8]; unpack8(yv[mm][bj], y); unpack8(zv[mm][bj], z);
#pragma unroll
                    for (int j = 0; j < 4; ++j) {
                        o[j] = y[j] * z[j] * __builtin_amdgcn_rcpf((1.0f + __expf(-(v0[j] + bb[bj][0][j]))) * (1.0f + __expf(-z[j])));
                        o[4 + j] = y[4 + j] * z[4 + j] * __builtin_amdgcn_rcpf((1.0f + __expf(-(v1[j] + bb[bj][1][j]))) * (1.0f + __expf(-z[4 + j]))); }
                    *(u32x4*)(ab + (size_t)(row0 + ai * 128 + m * 16) * 2048 + 1024 + colb + bj * 128) = pack8(o); } }
    }
};
struct EpiMergeF {
    static constexpr bool PERM = true, HAS_MID = true;
    const bf16_t* gt; bf16_t* mg;
    DI void mid(f32x4 (&acc)[2][2][4][2], const Unit& u, int wr, int wc, int fr, int fq) const {
        int row0 = u.pm * 256 + wr * 64 + fr, colb = u.pn * 256 + wc * 32 + 8 * fq; asm volatile("" : "+v"(row0), "+v"(colb));
#pragma unroll
        for (int ai = 0; ai < 2; ++ai)
#pragma unroll
            for (int mp = 0; mp < 2; ++mp) { u32x4 ga[2][2], gb[2][2];
#pragma unroll
                for (int mm = 0; mm < 2; ++mm)
#pragma unroll
                    for (int bj = 0; bj < 2; ++bj) { const bf16_t* gp = gt + (size_t)(row0 + ai * 128 + (mp * 2 + mm) * 16) * 4096 + colb + bj * 128; ga[mm][bj] = *(const u32x4*)gp; gb[mm][bj] = *(const u32x4*)(gp + 2048); }
#pragma unroll
                for (int mm = 0; mm < 2; ++mm)
#pragma unroll
                    for (int bj = 0; bj < 2; ++bj) { const int m = mp * 2 + mm; float a8[8], b8[8]; unpack8(ga[mm][bj], a8); unpack8(gb[mm][bj], b8);
#pragma unroll
                        for (int j = 0; j < 4; ++j) { acc[ai][bj][m][0][j] *= a8[j] * __builtin_amdgcn_rcpf(fmaxf(b8[j], 1e-30f)); acc[ai][bj][m][1][j] *= a8[4 + j] * __builtin_amdgcn_rcpf(fmaxf(b8[4 + j], 1e-30f)); } }
                asm volatile("" ::: "memory"); }
    }
    DI void operator()(const f32x4 (&acc)[2][2][4][2], const Unit& u, int wr, int wc, int fr, int fq) const {
        int row0 = u.pm * 256 + wr * 64 + fr, colb = u.pn * 256 + wc * 32 + 8 * fq; asm volatile("" : "+v"(row0), "+v"(colb));
#pragma unroll
        for (int ai = 0; ai < 2; ++ai) { u32x4 gb[4][2];
#pragma unroll
            for (int m = 0; m < 4; ++m)
#pragma unroll
                for (int bj = 0; bj < 2; ++bj) gb[m][bj] = *(const u32x4*)(gt + (size_t)(row0 + ai * 128 + m * 16) * 4096 + 2048 + colb + bj * 128);
#pragma unroll
            for (int m = 0; m < 4; ++m)
#pragma unroll
                for (int bj = 0; bj < 2; ++bj) { float b8[8], o[8]; unpack8(gb[m][bj], b8); const f32x4 v0 = acc[ai][bj][m][0], v1 = acc[ai][bj][m][1];
#pragma unroll
                    for (int j = 0; j < 4; ++j) { o[j] = b8[j] * v0[j]; o[4 + j] = b8[4 + j] * v1[j]; }
                    *(u32x4*)(mg + (size_t)(row0 + ai * 128 + m * 16) * 2048 + colb + bj * 128) = pack8(o); } }
    }
};
struct EpiOut {
    static constexpr bool PERM = false, HAS_MID = false;
    const float* xi; float* xo;
    DI void operator()(const f32x4 (&acc)[2][2][4][2], const Unit& u, int wr, int wc, int fr, int fq) const {
        const int row0 = u.pm * 256 + wr * 64 + fr, col0 = u.pn * 256 + wc * 32 + 4 * fq;
#pragma unroll
        for (int ai = 0; ai < 2; ++ai)
#pragma unroll
            for (int mp = 0; mp < 2; ++mp) { f32x4 rv[2][2][2];
#pragma unroll
                for (int mm = 0; mm < 2; ++mm)
#pragma unroll
                    for (int bj = 0; bj < 2; ++bj)
#pragma unroll
                        for (int n = 0; n < 2; ++n) rv[mm][bj][n] = *(const f32x4*)(xi + (size_t)(row0 + ai * 128 + (mp * 2 + mm) * 16) * DM + col0 + bj * 128 + n * 16);
#pragma unroll
                for (int mm = 0; mm < 2; ++mm)
#pragma unroll
                    for (int bj = 0; bj < 2; ++bj)
#pragma unroll
                        for (int n = 0; n < 2; ++n) *(f32x4*)(xo + (size_t)(row0 + ai * 128 + (mp * 2 + mm) * 16) * DM + col0 + bj * 128 + n * 16) = rv[mm][bj][n] + acc[ai][bj][mp * 2 + mm][n]; }
    }
};

DI void tr_item(const float* W, int N, int k0, int n0, bf16_t* dst, int Kp, LAS float* scr, int lane) {
    float wv[32];
#pragma unroll
    for (int i = 0; i < 32; ++i) { const int kk = 2 * i + (lane >> 5); wv[i] = W[(size_t)(k0 + kk) * N + n0 + (lane & 31)]; }
#pragma unroll
    for (int i = 0; i < 32; ++i) { const int kk = 2 * i + (lane >> 5); scr[kk * 33 + (lane & 31)] = wv[i]; }
    LDS_WAIT(); asm volatile("" ::: "memory");
    const int c = lane & 7;
#pragma unroll
    for (int j = 0; j < 4; ++j) { const int n = (lane >> 3) + 8 * j; const LAS float* s = scr + (8 * c) * 33 + n;
        u32x4 o; o.x = pk2(s[0 * 33], s[1 * 33]); o.y = pk2(s[2 * 33], s[3 * 33]); o.z = pk2(s[4 * 33], s[5 * 33]); o.w = pk2(s[6 * 33], s[7 * 33]);
        *(u32x4*)(dst + (size_t)n * Kp + k0 + 8 * c) = o; }
    LDS_WAIT(); asm volatile("" ::: "memory");
}

DI void s5_prep(const Args& a, int l, int g, LAS unsigned char* lds) {
    const int tid = ltid();
    LAS float* POWr = (LAS float*)lds;
    LAS float* POWi = POWr + 4224;
    LAS float* BBr = POWi + 4224;
    LAS float* BBi = BBr + 2048;
    LAS float* CCr = BBi + 2048;
    LAS float* CCi = CCr + 2048;
    LAS float* KK = CCi + 2048;
    const float *lam_re = a.in[7], *lam_im = a.in[8], *log_dt = a.in[9], *b_re = a.in[10], *b_im = a.in[11], *c_re = a.in[12], *c_im = a.in[13], *d_skip = a.in[14];
    if (tid < 128) {
        const int d = tid >> 6, p = tid & 63; const int idx = ((l * 2 + d) * NG + g) * NP + p;
        const float lr = lam_re[idx], li = lam_im[idx], dt = expf(log_dt[(l * 2 + d) * NG + g]);
        const double rev1 = (double)li * (double)dt * 0.15915494309189535;
        for (int k = 0; k <= 32; ++k) { double rv = rev1 * (double)k; rv -= rint(rv); const float rvf = (float)rv;
            const float e = expf((float)k * lr * dt), s = __builtin_amdgcn_sinf(rvf), c = __builtin_amdgcn_cosf(rvf);
            POWr[(d * 33 + k) * 64 + p] = e * c; POWi[(d * 33 + k) * 64 + p] = e * s; }
        double r1 = rev1; r1 -= rint(r1); double rh = rev1 * 0.5; rh -= rint(rh);
        const float em1 = expm1f(lr * dt), s1 = __builtin_amdgcn_sinf((float)r1), c1 = __builtin_amdgcn_cosf((float)r1), sh = __builtin_amdgcn_sinf((float)rh);
        const float cm1 = -2.f * sh * sh;
        const float nr = em1 * c1 + cm1, ni = (em1 + 1.f) * s1;
        const float den = lr * lr + li * li; const float cr = (nr * lr + ni * li) / den, ci = (ni * lr - nr * li) / den;
        for (int cp = 0; cp < 16; ++cp) { const float br = b_re[(size_t)idx * 16 + cp], bi = b_im[(size_t)idx * 16 + cp];
            BBr[(d * 64 + p) * 16 + cp] = cr * br - ci * bi; BBi[(d * 64 + p) * 16 + cp] = cr * bi + ci * br; }
    }
    for (int i = tid; i < 2048; i += NTHREADS) { const int d = i >> 10, c = (i >> 6) & 15, p = i & 63; const size_t cidx = ((size_t)((l * 2 + d) * NG + g) * 16 + c) * 64 + p; CCr[i] = c_re[cidx]; CCi[i] = c_im[cidx]; }
    __syncthreads();
    { const int d = tid >> 8, c = (tid >> 4) & 15, cp = tid & 15; const int lane = tid & 63, gbase = lane & 48;
      float bbr[64], bbi[64];
#pragma unroll
      for (int p = 0; p < 64; ++p) { bbr[p] = BBr[(d * 64 + p) * 16 + cp]; bbi[p] = BBi[(d * 64 + p) * 16 + cp]; }
      float ccr[4], cci[4];
#pragma unroll
      for (int q = 0; q < 4; ++q) { ccr[q] = CCr[(d * 16 + c) * 64 + cp * 4 + q]; cci[q] = CCi[(d * 16 + c) * 64 + cp * 4 + q]; }
      for (int k = 0; k < 32; ++k) { float zr[4], zi[4];
#pragma unroll
          for (int q = 0; q < 4; ++q) { const float pr = POWr[(d * 33 + k) * 64 + cp * 4 + q], pi = POWi[(d * 33 + k) * 64 + cp * 4 + q]; zr[q] = ccr[q] * pr - cci[q] * pi; zi[q] = ccr[q] * pi + cci[q] * pr; }
          float s = 0.f;
#pragma unroll
          for (int p = 0; p < 64; ++p) { const float ar = __shfl(zr[p & 3], gbase + (p >> 2)), ai = __shfl(zi[p & 3], gbase + (p >> 2)); s += ar * bbr[p] - ai * bbi[p]; }
          KK[(d * 32 + k) * 256 + c * 16 + cp] = s; } }
    __syncthreads();
    bf16_t* bty = (bf16_t*)(a.ws + WS_BTY + (size_t)l * SZ_BTY) + (size_t)g * 512 * KY;
    for (int ch = tid; ch < 512 * 96; ch += NTHREADS) { const int row = ch / 96, kk0 = (ch % 96) * 8, t = row >> 4, c = row & 15; float v[8];
        if (kk0 < 512) { const int s = kk0 >> 4, cp0 = kk0 & 15;
#pragma unroll
            for (int e = 0; e < 8; ++e) { const int cp = cp0 + e; float x;
                if (s < t) x = KK[(0 * 32 + (t - s)) * 256 + c * 16 + cp];
                else if (s > t) x = KK[(1 * 32 + (s - t)) * 256 + c * 16 + cp];
                else x = KK[c * 16 + cp] + KK[32 * 256 + c * 16 + cp] + (c == cp ? d_skip[l * WB + g * 16 + c] : 0.f);
                v[e] = x; } }
        else { const int d = kk0 < 640 ? 0 : 1, f = kk0 - 512 - d * 128, ri = f >> 6, p0 = f & 63, k = d ? (32 - t) : (t + 1);
#pragma unroll
            for (int e = 0; e < 8; ++e) { const int p = p0 + e; const float cr = CCr[(d * 16 + c) * 64 + p], ci = CCi[(d * 16 + c) * 64 + p], pr = POWr[(d * 33 + k) * 64 + p], pi = POWi[(d * 33 + k) * 64 + p];
                v[e] = ri ? -(cr * pi + ci * pr) : (cr * pr - ci * pi); } }
        *(u32x4*)(bty + (size_t)row * KY + kk0) = pack8(v); }
    bf16_t* bte = (bf16_t*)(a.ws + WS_BTE + (size_t)l * SZ_BTE) + (size_t)g * 256 * KE;
    for (int ch = tid; ch < 256 * 64; ch += NTHREADS) { const int row = ch >> 6, kk0 = (ch & 63) * 8, d = row >> 7, ri = (row >> 6) & 1, p = row & 63, s = kk0 >> 4, cp0 = kk0 & 15, k = d ? s : (31 - s);
        const float pr = POWr[(d * 33 + k) * 64 + p], pi = POWi[(d * 33 + k) * 64 + p]; float v[8];
#pragma unroll
        for (int e = 0; e < 8; ++e) { const float br = BBr[(d * 64 + p) * 16 + cp0 + e], bi = BBi[(d * 64 + p) * 16 + cp0 + e]; v[e] = ri ? (pr * bi + pi * br) : (pr * br - pi * bi); }
        *(u32x4*)(bte + (size_t)row * KE + kk0) = pack8(v); }
    __syncthreads();
}

struct TrTile { const float* W; bf16_t* dst; int N, Kp; };
DI bool tr_decode(const Args& a, int it, TrTile& t) {
    constexpr int T0 = 32 * 40, T1 = 16 * 4, T2 = 16 * 8, T3 = 16 * 8, T4 = 32 * 8, TL = T0 + T1 + T2 + T3 + T4;
    if (it >= DEPTH * TL) return false;
    const int l = it / TL; int r = it % TL;
    if (r < T0) { const int kb = r / 40, tt = r % 40, n0 = tt < 16 ? tt * 256 : 4128 + (tt - 16) * 256;
        t.W = a.in[2] + (size_t)l * DM * PROJ + (size_t)(kb * 64) * PROJ + n0; t.N = PROJ; t.Kp = DM; t.dst = (bf16_t*)(a.ws + WS_WIN + (size_t)l * SZ_WIN) + (size_t)(tt * 256) * DM + kb * 64; return true; } r -= T0;
    if (r < T1) { const int kb = r / 4, tt = r % 4; t.W = a.in[15] + (size_t)l * WB * WB + (size_t)(kb * 64) * WB + tt * 256; t.N = WB; t.Kp = WB; t.dst = (bf16_t*)(a.ws + WS_WGLU + (size_t)l * SZ_WGLU) + (size_t)(tt * 256) * WB + kb * 64; return true; } r -= T1;
    if (r < T2) { const int kb = r / 8, tt = r % 8; t.W = a.in[17] + (size_t)l * WA * DM + (size_t)(kb * 64) * DM + tt * 256; t.N = DM; t.Kp = 2048; t.dst = (bf16_t*)(a.ws + WS_WPA + (size_t)l * 2 * SZ_WPA) + (size_t)(tt * 256) * 2048 + kb * 64; return true; } r -= T2;
    if (r < T3) { const int kb = r / 8, tt = r % 8; t.W = a.in[18] + (size_t)l * WB * DM + (size_t)(kb * 64) * DM + tt * 256; t.N = DM; t.Kp = 2048; t.dst = (bf16_t*)(a.ws + WS_WPA + (size_t)l * 2 * SZ_WPA) + (size_t)(tt * 256) * 2048 + 1024 + kb * 64; return true; } r -= T3;
    { const int kb = r / 8, tt = r % 8; t.W = a.in[20] + (size_t)l * DM * DM + (size_t)(kb * 64) * DM + tt * 256; t.N = DM; t.Kp = DM; t.dst = (bf16_t*)(a.ws + WS_WOUT + (size_t)l * SZ_WOUT) + (size_t)(tt * 256) * DM + kb * 64; return true; }
}
DI void phase_prologue(const Args& a, LAS unsigned char* lds) {
    const int tid = ltid(), lane = tid & 63, wave = tid >> 6, G = gridDim.x;
    const bool s5_last = ((blockIdx.x >> 3) & 1) != 0;
    if (!s5_last) { for (int it = blockIdx.x; it < DEPTH * NG; it += G) s5_prep(a, it >> 6, it & 63, lds); }
    __syncthreads();
    { LAS float* scr = (LAS float*)(lds + wave * 8448); const int gw = blockIdx.x * NWAVES + wave, NGW = G * NWAVES;
      for (int it = gw; it < DEPTH * 32; it += NGW) { const int l = it >> 5, kb = it & 31;
          tr_item(a.in[2] + (size_t)l * DM * PROJ, PROJ, kb * 64, 4096, (bf16_t*)(a.ws + WS_WBA + (size_t)l * SZ_WBA), DM, scr, lane); } }
    __syncthreads();
    LAS float* T = (LAS float*)lds;
    TrTile cur; int it = blockIdx.x; bool have = tr_decode(a, it, cur);
    f32x4 v[8];
    if (have) {
#pragma unroll
        for (int i = 0; i < 8; ++i) v[i] = *(const f32x4*)(cur.W + (size_t)(wave * 8 + i) * cur.N + 4 * lane); }
    while (have) {
#pragma unroll
        for (int i = 0; i < 8; ++i) *(LAS f32x4*)(T + (wave * 8 + i) * 260 + 4 * (lane ^ wave)) = v[i];
        LBAR();
        TrTile nxt; const bool hn = tr_decode(a, it + G, nxt);
        if (hn) {
#pragma unroll
            for (int i = 0; i < 8; ++i) v[i] = *(const f32x4*)(nxt.W + (size_t)(wave * 8 + i) * nxt.N + 4 * lane); }
#pragma unroll
        for (int p = 0; p < 4; ++p) { const int task = tid + 512 * p, n = task >> 3, c = task & 7; const LAS float* sp = T + (8 * c) * 260 + 4 * ((n >> 2) ^ c) + (n & 3);
            u32x4 o; o.x = pk2(sp[0 * 260], sp[1 * 260]); o.y = pk2(sp[2 * 260], sp[3 * 260]); o.z = pk2(sp[4 * 260], sp[5 * 260]); o.w = pk2(sp[6 * 260], sp[7 * 260]);
            *(u32x4*)(cur.dst + (size_t)n * cur.Kp + 8 * c) = o; }
        LBAR();
        cur = nxt; have = hn; it += G;
    }
    if (s5_last) { __syncthreads(); for (int it2 = blockIdx.x; it2 < DEPTH * NG; it2 += G) s5_prep(a, it2 >> 6, it2 & 63, lds); }
}

DI void phase_norm(const Args& a, int l, LAS unsigned char* lds) {
    const int tid = ltid(), lane = tid & 63, wave = tid >> 6, G = gridDim.x;
    const float* xin = l == 0 ? a.in[0] : (const float*)(a.ws + WS_X);
    const float* lng = a.in[1] + (size_t)l * DM;
    bf16_t* H = (bf16_t*)(a.ws + WS_H);
    const bf16_t* wba = (const bf16_t*)(a.ws + WS_WBA + (size_t)l * SZ_WBA);
    float* BA = (float*)(a.ws + WS_BA);
    for (int rg = blockIdx.x; rg < MTOK / 32; rg += G) {
        for (int rr = 0; rr < 4; ++rr) { const int row = rg * 32 + wave * 4 + rr;
            const f32x4* xr = (const f32x4*)(xin + (size_t)row * DM) + lane; f32x4 v[8]; float s = 0.f;
#pragma unroll
            for (int j = 0; j < 8; ++j) { v[j] = xr[64 * j]; s += (v[j].x * v[j].x + v[j].y * v[j].y) + (v[j].z * v[j].z + v[j].w * v[j].w); }
            const float rstd = rsqrtf(wave_sum(s) * (1.f / DM) + RMS_EPS);
            u32x2* o8 = (u32x2*)(H + (size_t)row * DM) + lane;
#pragma unroll
            for (int j = 0; j < 8; ++j) { const f32x4 gg = ((const f32x4*)lng)[lane + 64 * j]; u32x2 w; w.x = pk2(v[j].x * rstd * gg.x, v[j].y * rstd * gg.y); w.y = pk2(v[j].z * rstd * gg.z, v[j].w * rstd * gg.w); o8[64 * j] = w; }
        }
        __syncthreads();
        { const int r = lane & 31, hh = lane >> 5; f32x16 acc;
#pragma unroll
          for (int i = 0; i < 16; ++i) acc[i] = 0.f;
          const bf16_t* ap = H + (size_t)(rg * 32 + r) * DM + wave * 256 + 8 * hh; const bf16_t* bp = wba + (size_t)r * DM + wave * 256 + 8 * hh;
#pragma unroll 4
          for (int i = 0; i < 16; ++i) { const bf16x8 af = *(const bf16x8*)(ap + 16 * i), bfr = *(const bf16x8*)(bp + 16 * i); acc = MFMA32(af, bfr, acc); }
          LAS float* red = (LAS float*)lds + wave * 1024;
#pragma unroll
          for (int i = 0; i < 16; ++i) red[crow(i, hh) * 32 + r] = acc[i];
        }
        __syncthreads();
        for (int o = tid; o < 1024; o += NTHREADS) { float s = 0.f;
#pragma unroll
            for (int w = 0; w < 8; ++w) s += ((LAS float*)lds)[w * 1024 + o];
            BA[(size_t)(rg * 32 + (o >> 5)) * 32 + (o & 31)] = s; }
        __syncthreads();
    }
}

DI bf16_t* rec_ptr(const Args& a, int b, int h, int dir, int j) { return (bf16_t*)(a.ws + WS_REC + (size_t)(((b * NH + h) * 2 + dir) * 32 + j) * REC_BYTES); }
constexpr int REC_W = 0, REC_U = 8192, REC_QG = 16384, REC_KDT = 24576, REC_QK = 32768;


template <int DIR>
DI void solve_T(const LAS float* LM, const LAS float* SM, LAS unsigned short* AMv, LAS unsigned short* AMw, int cp) {
    const LAS float* Lm = LM + DIR * 4096;
    const int c = DIR ? 63 - cp : cp; const float sv = SM[DIR * 64 + c], sw = sv * SM[256 + DIR * 64 + c];
    LAS unsigned short* ov = AMv + c; LAS unsigned short* ow = AMw + c;
    typedef float f32x2p __attribute__((ext_vector_type(2)));
    f32x2p xs[32];
#pragma unroll
    for (int q = 0; q < 32; ++q) xs[q] = (f32x2p){0.f, 0.f};
    f32x4 cur[16], nxt[16];
#pragma unroll
    for (int q = 0; q < 16; ++q) { cur[q] = (f32x4){0.f, 0.f, 0.f, 0.f}; nxt[q] = (f32x4){0.f, 0.f, 0.f, 0.f}; }
#pragma unroll
    for (int rp = 0; rp < 64; ++rp) { const int r = DIR ? 63 - rp : rp;
        asm volatile("" ::: "memory");
        if (rp + 1 < 64) {
#pragma unroll
            for (int s4 = 0; s4 < (rp + 1 + 3) / 4; ++s4) nxt[s4] = *(const LAS f32x4*)(Lm + (rp + 1) * 64 + 4 * s4); }
        float bv = (rp == cp) ? 1.f : 0.f;
        f32x2p pa[2] = {(f32x2p){0.f, 0.f}, (f32x2p){0.f, 0.f}}, pb[2] = {(f32x2p){0.f, 0.f}, (f32x2p){0.f, 0.f}};
#pragma unroll
        for (int s4 = 0; s4 < (rp + 3) / 4; ++s4) { const f32x2p la = (f32x2p){cur[s4].x, cur[s4].y}, lb = (f32x2p){cur[s4].z, cur[s4].w};
            pa[s4 & 1] += la * xs[2 * s4]; pb[s4 & 1] += lb * xs[2 * s4 + 1]; }
        const f32x2p pt = (pa[0] + pa[1]) + (pb[0] + pb[1]);
        bv -= pt.x + pt.y;
        if (rp & 1) xs[rp >> 1].y = bv; else xs[rp >> 1].x = bv;
        ov[r * 72] = (unsigned short)(pk2(bv * sv, 0.f) & 0xffffu); ow[r * 72] = (unsigned short)(pk2(bv * sw, 0.f) & 0xffffu);
#pragma unroll
        for (int q = 0; q < 16; ++q) cur[q] = nxt[q]; }
}

DI void prep_unit(const Args& a, int l, int pu, LAS unsigned char* lds) {
    const int tid = ltid(), lane = tid & 63, wave = tid >> 6;
    asm volatile("" : "+s"(pu));
    const int h = pu & 7, j = (pu >> 3) & 31, b = pu >> 8;
    constexpr int RAW_PITCH = 784;
    LAS unsigned char* RAW = lds;
    LAS float* LM = (LAS float*)lds;
    LAS unsigned short* AM = (LAS unsigned short*)(lds + 33856);
    LAS unsigned short* KB = (LAS unsigned short*)(lds + 53312);
    LAS unsigned short* QB = (LAS unsigned short*)(lds + 70720);
    LAS unsigned short* VT = (LAS unsigned short*)(lds + 88128);
    LAS unsigned short* KT = (LAS unsigned short*)(lds + 106560);
    LAS float* SM = (LAS float*)(lds + 124992);
    const bf16_t* pq = (const bf16_t*)(a.ws + WS_PQKV);
    for (int ci = tid; ci < 68 * 48; ci += NTHREADS) { const int rr = ci / 48, rem = ci % 48, tn = rem >> 4, c16 = rem & 15; const int tok = j * 64 - 2 + rr;
        u32x4 v = (u32x4){0u, 0u, 0u, 0u};
        if (tok >= 0 && tok < SEQ) v = *(const u32x4*)(pq + (size_t)(b * SEQ + tok) * 3072 + tn * 1024 + h * 128 + c16 * 8);
        *(LAS u32x4*)(RAW + rr * RAW_PITCH + tn * 256 + c16 * 16) = v; }
    LBAR();
    if (tid < 384) { const int tn = tid >> 7, rb = (tid & 127) >> 3, cs = tid & 7, r0 = rb * 4; const float* cw = a.in[3] + (size_t)l * 5 * 3072 + tn * 1024 + h * 128 + cs * 16;
        f32x4 w[5][4];
#pragma unroll
        for (int i = 0; i < 5; ++i) { const f32x4* wp = (const f32x4*)(cw + (size_t)i * 3072); w[i][0] = wp[0]; w[i][1] = wp[1]; w[i][2] = wp[2]; w[i][3] = wp[3]; }
        float acc[4][16];
#pragma unroll
        for (int jj = 0; jj < 4; ++jj)
#pragma unroll
            for (int c = 0; c < 16; ++c) acc[jj][c] = 0.f;
#pragma unroll
        for (int rr = 0; rr < 8; ++rr) { const LAS u32x4* xp = (const LAS u32x4*)(RAW + (r0 + rr) * RAW_PITCH + tn * 256 + cs * 32); float x[16]; { float x0[8], x1[8]; unpack8(xp[0], x0); unpack8(xp[1], x1);
#pragma unroll
              for (int c = 0; c < 8; ++c) { x[c] = x0[c]; x[8 + c] = x1[c]; } }
#pragma unroll
            for (int jj = 0; jj < 4; ++jj) { const int i = rr - jj; if (i >= 0 && i < 5) {
#pragma unroll
                for (int c = 0; c < 16; ++c) acc[jj][c] += x[c] * w[i][c >> 2][c & 3]; } } }
        float rs[4];
#pragma unroll
        for (int jj = 0; jj < 4; ++jj) { float ss = 0.f;
#pragma unroll
            for (int c = 0; c < 16; ++c) { acc[jj][c] = siluf_(acc[jj][c]); ss += acc[jj][c] * acc[jj][c]; }
            ss += __shfl_xor(ss, 1); ss += __shfl_xor(ss, 2); ss += __shfl_xor(ss, 4);
            rs[jj] = tn == 2 ? 1.f : rsqrtf(ss + RMS_EPS) * (tn == 0 ? 0.08838834764831845f : 1.0f);
#pragma unroll
            for (int c = 0; c < 16; ++c) acc[jj][c] *= rs[jj];
            if (tn < 2) { LAS unsigned short* dst = (tn == 0 ? QB : KB) + (r0 + jj) * 136 + cs * 16;
#pragma unroll
                for (int c = 0; c < 16; c += 2) *(LAS unsigned*)(dst + c) = pk2(acc[jj][c], acc[jj][c + 1]); } }
        if (tn >= 1) { LAS unsigned short* tp = (tn == 1 ? KT : VT) + (cs * 16) * 72 + r0;
#pragma unroll
            for (int c = 0; c < 16; ++c) { u32x2 wv; wv.x = pk2(acc[0][c], acc[1][c]); wv.y = pk2(acc[2][c], acc[3][c]); *(LAS u32x2*)(tp + c * 72) = wv; } } }
    if (wave == 7) {
        const int tok = b * SEQ + j * 64 + lane; const float* ba = (const float*)(a.ws + WS_BA) + (size_t)tok * 32;
        const float blf = ba[h], blb = ba[8 + h], alf = ba[16 + h], alb = ba[24 + h];
        const float af = expf(a.in[4][(l * 2 + 0) * NH + h]), ab = expf(a.in[4][(l * 2 + 1) * NH + h]);
        const float xf = alf + a.in[5][(l * 2 + 0) * NH + h], xb = alb + a.in[5][(l * 2 + 1) * NH + h];
        const float spf = xf > 20.f ? xf : log1pf(expf(xf)), spb = xb > 20.f ? xb : log1pf(expf(xb));
        const float gf = -af * spf, gb = -ab * spb;
        float pf = gf, pb = gb;
#pragma unroll
        for (int o = 1; o < 64; o <<= 1) { const float tf = __shfl_up(pf, o), tb = __shfl_up(pb, o); if (lane >= o) { pf += tf; pb += tb; } }
        const float totb = __shfl(pb, 63); const float gcb = totb - pb + gb;
        SM[lane] = sigmoidf_(blf); SM[64 + lane] = sigmoidf_(blb); SM[128 + lane] = pf; SM[192 + lane] = gcb; SM[256 + lane] = expf(pf); SM[320 + lane] = expf(gcb); }
    LBAR();
    bf16_t* rec[2] = {rec_ptr(a, b, h, 0, j), rec_ptr(a, b, h, 1, j)};
    { const int mat = wave >> 2, mb = wave & 1, nb = (wave >> 1) & 1, r = lane & 31, hh = lane >> 5; f32x16 acc;
#pragma unroll
      for (int i = 0; i < 16; ++i) acc[i] = 0.f;
      const LAS unsigned short* Ap = (mat ? QB : KB) + (32 * mb + r) * 136 + 8 * hh; const LAS unsigned short* Bp = KB + (32 * nb + r) * 136 + 8 * hh;
#pragma unroll
      for (int ks = 0; ks < 8; ++ks) { const bf16x8 af = *(const LAS bf16x8*)(Ap + 16 * ks), bfr = *(const LAS bf16x8*)(Bp + 16 * ks); acc = MFMA32(af, bfr, acc); }
      const int s = 32 * nb + r; const float gcf_s = SM[128 + s], gcb_s = SM[192 + s];
#pragma unroll
      for (int i = 0; i < 16; ++i) { const int c = 32 * mb + crow(i, hh); const float df = SM[128 + c] - gcf_s, db = SM[192 + c] - gcb_s;
          const float ef = __expf(fminf(df, 0.f)), eb = __expf(fminf(db, 0.f));
          if (mat == 0) { LM[c * 64 + s] = (c > s) ? SM[c] * acc[i] * ef : 0.f; LM[4096 + (63 - c) * 64 + (63 - s)] = (c < s) ? SM[64 + c] * acc[i] * eb : 0.f; }
          else { rec[0][REC_QK + c * 64 + s] = (bf16_t)(pk2((c >= s) ? acc[i] * ef : 0.f, 0.f) & 0xffffu); rec[1][REC_QK + c * 64 + s] = (bf16_t)(pk2((c <= s) ? acc[i] * eb : 0.f, 0.f) & 0xffffu); } } }
    LBAR();
    if (wave == 0) solve_T<0>(LM, SM, AM, AM + 4608, lane);
    else if (wave == 1) solve_T<1>(LM, SM, AM + 9216, AM + 13824, lane);
    else {
        for (int it = tid - 128; it < 512; it += 384) { const int r = it >> 3, cs = it & 7; const float ef = SM[256 + r], eb = SM[320 + r]; float o[8];
            const LAS u32x4* qp = (const LAS u32x4*)(QB + r * 136 + cs * 16); float q0[8], q1[8]; unpack8(qp[0], q0); unpack8(qp[1], q1);
#pragma unroll
            for (int d = 0; d < 2; ++d) { const float e = d ? eb : ef;
#pragma unroll
                for (int c = 0; c < 8; ++c) o[c] = q0[c] * e;
                *(u32x4*)(rec[d] + REC_QG + r * 128 + cs * 16) = pack8(o);
#pragma unroll
                for (int c = 0; c < 8; ++c) o[c] = q1[c] * e;
                *(u32x4*)(rec[d] + REC_QG + r * 128 + cs * 16 + 8) = pack8(o); } }
        const float glf = SM[128 + 63], glb = SM[192 + 0];
        for (int it = tid - 128; it < 512; it += 384) { const int dd = it >> 2, cq = it & 3; float k0[8], k1[8];
            const LAS u32x4* kp = (const LAS u32x4*)(KT + dd * 72 + cq * 16); unpack8(kp[0], k0); unpack8(kp[1], k1);
#pragma unroll
            for (int d = 0; d < 2; ++d) { float o[8];
#pragma unroll
                for (int i = 0; i < 8; ++i) { const int c = cq * 16 + i; o[i] = k0[i] * (d ? __expf(glb - SM[192 + c]) : __expf(glf - SM[128 + c])); }
                *(u32x4*)(rec[d] + REC_KDT + dd * 64 + cq * 16) = pack8(o);
#pragma unroll
                for (int i = 0; i < 8; ++i) { const int c = cq * 16 + 8 + i; o[i] = k1[i] * (d ? __expf(glb - SM[192 + c]) : __expf(glf - SM[128 + c])); }
                *(u32x4*)(rec[d] + REC_KDT + dd * 64 + cq * 16 + 8) = pack8(o); } }
        if (tid == 128) { float* eg = (float*)(a.ws + WS_EGP); eg[(size_t)(((b * NH + h) * 2 + 0) * 32 + j) * 32] = __expf(glf); eg[(size_t)(((b * NH + h) * 2 + 1) * 32 + j) * 32] = __expf(glb); }
    }
    LBAR();
    { const int p = wave >> 1, mb = wave & 1, r = lane & 31, hh = lane >> 5;
      const LAS unsigned short* Ap = AM + p * 4608 + (32 * mb + r) * 72 + 8 * hh; const LAS unsigned short* Bt = (p & 1) ? KT : VT;
      bf16x8 af[4];
#pragma unroll
      for (int ks = 0; ks < 4; ++ks) af[ks] = *(const LAS bf16x8*)(Ap + 16 * ks);
      bf16_t* outp = rec[p >> 1] + ((p & 1) ? REC_W : REC_U) + (32 * mb) * 128 + r;
#pragma unroll
      for (int nbk = 0; nbk < 4; ++nbk) { f32x16 acc;
#pragma unroll
          for (int i = 0; i < 16; ++i) acc[i] = 0.f;
          const LAS unsigned short* Bp = Bt + (32 * nbk + r) * 72 + 8 * hh;
#pragma unroll
          for (int ks = 0; ks < 4; ++ks) { const bf16x8 bfr = *(const LAS bf16x8*)(Bp + 16 * ks); acc = MFMA32(af[ks], bfr, acc); }
#pragma unroll
          for (int i = 0; i < 16; ++i) outp[crow(i, hh) * 128 + 32 * nbk] = (bf16_t)(pk2(acc[i], 0.f) & 0xffffu); } }
    LBAR();
}

DI void scan_unit(const Args& a, int su, LAS unsigned char* lds) {
    const int tid = ltid(), lane = tid & 63, wave = tid >> 6, r = lane & 31, hh = lane >> 5;
    const int vs = su & 1, dir = (su >> 1) & 1, h = (su >> 2) & 7, b = su >> 5;
    LAS unsigned char* Lw = lds;
    LAS unsigned char* Lqg = lds + 17408;
    LAS unsigned char* Lkd0 = lds + 34816;
    LAS unsigned char* Lqk0 = lds + 71680;
    LAS unsigned char* Lu = lds + 90112;
    LAS unsigned char* LS = lds + 99328;
    LAS unsigned char* LV = lds + 116736;
    const float* EG = (const float*)(a.ws + WS_EGP) + (size_t)(((b * NH + h) * 2 + dir) * 32) * 32;
    const float egv = EG[(lane & 31) * 32];
    float* O = (float*)(a.ws + WS_OF) + (size_t)dir * MTOK * 1024;
    for (int i = tid; i < 17408 / 4; i += NTHREADS) ((LAS unsigned*)LS)[i] = 0u;
    f32x16 Sacc;
#pragma unroll
    for (int i = 0; i < 16; ++i) Sacc[i] = 0.f;
    u32x4 preA[8], preB[8];
#define SCAN_PREFETCH(pre, jx) do { const unsigned char* rb = (const unsigned char*)rec_ptr(a, b, h, dir, (jx)); \
        _Pragma("unroll") for (int i = 0; i < 2; ++i) { const int ci = tid + 512 * i; pre[i] = *(const u32x4*)(rb + REC_W * 2 + (ci >> 4) * 256 + (ci & 15) * 16); pre[2 + i] = *(const u32x4*)(rb + REC_QG * 2 + (ci >> 4) * 256 + (ci & 15) * 16); \
            pre[4 + i] = *(const u32x4*)(rb + REC_KDT * 2 + (ci >> 3) * 128 + (ci & 7) * 16); } \
        pre[6] = *(const u32x4*)(rb + REC_QK * 2 + (tid >> 3) * 128 + (tid & 7) * 16); \
        pre[7] = *(const u32x4*)(rb + REC_U * 2 + (tid >> 3) * 256 + vs * 128 + (tid & 7) * 16); } while (0)
    SCAN_PREFETCH(preA, dir ? 31 : 0);
    SCAN_PREFETCH(preB, dir ? 30 : 1);
    const int mb = wave & 1, nb = (wave >> 1) & 1, kb = wave & 3, nb2 = wave >> 2;
#define SCAN_STEP(pre, step) do { const int j = dir ? 31 - (step) : (step); LAS unsigned char* Lkd = Lkd0 + ((step) & 1) * 18432; LAS unsigned char* Lqk = Lqk0 + ((step) & 1) * 9216; \
        _Pragma("unroll") for (int i = 0; i < 2; ++i) { const int ci = tid + 512 * i; *(LAS u32x4*)(Lw + (ci >> 4) * 272 + (ci & 15) * 16) = pre[i]; *(LAS u32x4*)(Lqg + (ci >> 4) * 272 + (ci & 15) * 16) = pre[2 + i]; \
            *(LAS u32x4*)(Lkd + (ci >> 3) * 144 + (ci & 7) * 16) = pre[4 + i]; } \
        *(LAS u32x4*)(Lqk + (tid >> 3) * 144 + (tid & 7) * 16) = pre[6]; \
        *(LAS u32x4*)(Lu + (tid >> 3) * 144 + (tid & 7) * 16) = pre[7]; \
        LBAR(); \
        if ((step) + 2 < 32) SCAN_PREFETCH(pre, dir ? 29 - (step) : (step) + 2); \
        const float eg = __shfl(egv, j); \
        f32x16 acc; \
        _Pragma("unroll") for (int i = 0; i < 16; ++i) acc[i] = 0.f; \
        { const LAS unsigned char* Ap = (wave < 4 ? Lw : Lqg) + (32 * mb + r) * 272 + 16 * hh; const LAS unsigned char* Bp = LS + (32 * nb + r) * 272 + 16 * hh; \
          __builtin_amdgcn_s_setprio(1); _Pragma("unroll") for (int ks = 0; ks < 8; ++ks) { const bf16x8 af = *(const LAS bf16x8*)(Ap + 32 * ks), bfr = *(const LAS bf16x8*)(Bp + 32 * ks); acc = MFMA32(af, bfr, acc); } __builtin_amdgcn_s_setprio(0); } \
        if (wave < 4) { \
            _Pragma("unroll") for (int g4 = 0; g4 < 4; ++g4) { float vn[4]; \
                _Pragma("unroll") for (int jj = 0; jj < 4; ++jj) { const int row = 32 * mb + 8 * g4 + 4 * hh + jj; vn[jj] = bf2f(*(const LAS unsigned short*)(Lu + row * 144 + (32 * nb + r) * 2)) - acc[4 * g4 + jj]; } \
                u32x2 w; w.x = pk2(vn[0], vn[1]); w.y = pk2(vn[2], vn[3]); \
                *(LAS u32x2*)(LV + (32 * nb + r) * 144 + (32 * mb + 8 * g4 + 4 * hh) * 2) = w; } } \
        LBAR(); \
        if (wave >= 4) { \
            const LAS unsigned char* Ap = Lqk + (32 * mb + r) * 144 + 16 * hh; const LAS unsigned char* Bp = LV + (32 * nb + r) * 144 + 16 * hh; \
            _Pragma("unroll") for (int ks = 0; ks < 4; ++ks) { const bf16x8 af = *(const LAS bf16x8*)(Ap + 32 * ks), bfr = *(const LAS bf16x8*)(Bp + 32 * ks); acc = MFMA32(af, bfr, acc); } \
            float* op = O + (size_t)(b * SEQ + j * 64 + 32 * mb) * 1024 + h * 128 + vs * 64 + 32 * nb + r; \
            _Pragma("unroll") for (int i = 0; i < 16; ++i) op[(size_t)crow(i, hh) * 1024] = acc[i]; \
        } \
        { \
            _Pragma("unroll") for (int i = 0; i < 16; ++i) Sacc[i] *= eg; \
            const LAS unsigned char* Ap = Lkd + (32 * kb + r) * 144 + 16 * hh; const LAS unsigned char* Bp = LV + (32 * nb2 + r) * 144 + 16 * hh; \
            _Pragma("unroll") for (int ks = 0; ks < 4; ++ks) { const bf16x8 af = *(const LAS bf16x8*)(Ap + 32 * ks), bfr = *(const LAS bf16x8*)(Bp + 32 * ks); Sacc = MFMA32(af, bfr, Sacc); } \
        } \
        _Pragma("unroll") for (int g4 = 0; g4 < 4; ++g4) { u32x2 w; w.x = pk2(Sacc[4 * g4], Sacc[4 * g4 + 1]); w.y = pk2(Sacc[4 * g4 + 2], Sacc[4 * g4 + 3]); \
            *(LAS u32x2*)(LS + (32 * nb2 + r) * 272 + (32 * kb + 8 * g4 + 4 * hh) * 2) = w; } \
    } while (0)
    for (int step = 0; step < 32; step += 2) { SCAN_STEP(preA, step); SCAN_STEP(preB, step + 1); }
#undef SCAN_STEP
#undef SCAN_PREFETCH
    __syncthreads();
}

DI void s5_carry(const Args& a, int l, int g) {
    const int tid = ltid(), bq = tid >> 7, dir = (tid >> 6) & 1, p = tid & 63;
    const int idx = ((l * 2 + dir) * NG + g) * NP + p;
    const float lr = a.in[7][idx], li = a.in[8][idx], dt = expf(a.in[9][(l * 2 + dir) * NG + g]);
    double rv = (double)li * (double)dt * 0.15915494309189535 * 32.0; rv -= rint(rv);
    const float e = expf(32.f * lr * dt), Tr = e * __builtin_amdgcn_cosf((float)rv), Ti = e * __builtin_amdgcn_sinf((float)rv);
    const float* E = (const float*)(a.ws + WS_EBUF) + (size_t)g * 256 * 256 + dir * 128 + p;
    bf16_t* A = (bf16_t*)(a.ws + WS_AS5) + (size_t)g * 256 * KY + 512 + dir * 128 + p;
    float cr = 0.f, ci = 0.f;
    for (int j0 = 0; j0 < 64; j0 += 16) { float er[16], ei[16];
#pragma unroll
        for (int k = 0; k < 16; ++k) { const int n = bq * 64 + (dir ? 63 - (j0 + k) : (j0 + k)); er[k] = E[(size_t)n * 256]; ei[k] = E[(size_t)n * 256 + 64]; }
#pragma unroll
        for (int k = 0; k < 16; ++k) { const int n = bq * 64 + (dir ? 63 - (j0 + k) : (j0 + k));
            A[(size_t)n * KY] = (bf16_t)(pk2(cr, 0.f) & 0xffffu); A[(size_t)n * KY + 64] = (bf16_t)(pk2(ci, 0.f) & 0xffffu);
            const float nr = Tr * cr - Ti * ci + er[k], ni = Tr * ci + Ti * cr + ei[k]; cr = nr; ci = ni; } }
    __syncthreads();
}

DI void post_a_rows2(const Args& a, int l, int tok0, int tok1, int lane) {
    const float* hg = a.in[6] + (size_t)l * HD + (lane & 7) * 16;
    f32x4 xf[2][4], xb[2][4]; u32x4 zz[2][2];
#pragma unroll
    for (int t = 0; t < 2; ++t) { const int tok = t ? tok1 : tok0;
        const float* of = (const float*)(a.ws + WS_OF) + (size_t)tok * 1024 + lane * 16; const float* ob = of + (size_t)MTOK * 1024;
        const u32x4* zp = (const u32x4*)((const bf16_t*)(a.ws + WS_ZA) + (size_t)tok * 1024 + lane * 16);
#pragma unroll
        for (int c = 0; c < 4; ++c) { xf[t][c] = ((const f32x4*)of)[c]; xb[t][c] = ((const f32x4*)ob)[c]; }
        zz[t][0] = zp[0]; zz[t][1] = zp[1]; }
#pragma unroll
    for (int t = 0; t < 2; ++t) { const int tok = t ? tok1 : tok0;
        float o[16]; float ss = 0.f;
#pragma unroll
        for (int c = 0; c < 4; ++c) { const f32x4 x = xf[t][c] + xb[t][c]; o[4 * c] = x.x; o[4 * c + 1] = x.y; o[4 * c + 2] = x.z; o[4 * c + 3] = x.w; ss += (x.x * x.x + x.y * x.y) + (x.z * x.z + x.w * x.w); }
        ss += __shfl_xor(ss, 1); ss += __shfl_xor(ss, 2); ss += __shfl_xor(ss, 4);
        const float rs = rsqrtf(ss * (1.f / HD) + RMS_EPS);
        float z0[8], z1[8]; unpack8(zz[t][0], z0); unpack8(zz[t][1], z1);
        float r0[8], r1[8];
#pragma unroll
        for (int c = 0; c < 8; ++c) { r0[c] = o[c] * rs * hg[c] * siluf_(z0[c]); r1[c] = o[8 + c] * rs * hg[8 + c] * siluf_(z1[c]); }
        u32x4* dp = (u32x4*)((bf16_t*)(a.ws + WS_AA) + (size_t)tok * 2048 + lane * 16); dp[0] = pack8(r0); dp[1] = pack8(r1); }
}

DI void final_row(const Args& a, int row, int lane) {
    const f32x4* xr = (const f32x4*)((const float*)(a.ws + WS_X) + (size_t)row * DM) + lane; f32x4 v[8]; float s = 0.f;
#pragma unroll
    for (int j = 0; j < 8; ++j) { v[j] = xr[64 * j]; s += (v[j].x * v[j].x + v[j].y * v[j].y) + (v[j].z * v[j].z + v[j].w * v[j].w); }
    const float rstd = rsqrtf(wave_sum(s) * (1.f / DM) + RMS_EPS);
    f32x4* o = (f32x4*)(a.out + (size_t)row * DM) + lane;
#pragma unroll
    for (int j = 0; j < 8; ++j) { const f32x4 gg = ((const f32x4*)a.in[21])[lane + 64 * j]; o[64 * j] = v[j] * rstd * gg; }
}


#define XB_TMO      128
#define XB_XCNT(j)  (256  + 64 * (j))
#define XB_XSUB(j)  (1280 + 64 * (j))
#define XB_XGEN(j)  (2304 + 64 * (j))
#define XB_TOP      3328
#define XB_TOPGEN   3392
#define XCD_BAR_WORDS 3456
#define XB_SPIN_CAP (1u << 22)
DI unsigned xb_ld(unsigned* p)              { return __hip_atomic_load(p, __ATOMIC_RELAXED, __HIP_MEMORY_SCOPE_AGENT); }
DI unsigned xb_add(unsigned* p, unsigned v) { return __hip_atomic_fetch_add(p, v, __ATOMIC_RELAXED, __HIP_MEMORY_SCOPE_AGENT); }
DI unsigned xb_xcc_id() { return (unsigned)__builtin_amdgcn_s_getreg((3 << 11) | 20) & 0xFu; }
#define XB_SPIN(cond, bar) do { unsigned _sp = 0; while (cond) { __builtin_amdgcn_s_sleep(1); \
    if ((++_sp & 255u) == 0u) { if (xb_ld(&(bar)[XB_TMO])) break; if (_sp > XB_SPIN_CAP) { atomicAdd(&(bar)[XB_TMO], 1u); break; } } } } while (0)
struct XcdBarrier { unsigned* bar; unsigned x; volatile LAS unsigned* st; };
DI XcdBarrier xcd_barrier_post(unsigned* bar, volatile LAS unsigned* st) {
    XcdBarrier b; b.bar = bar; b.x = xb_xcc_id(); b.st = st;
    if (__builtin_amdgcn_workitem_id_x() == 0) (void)xb_add(&bar[XB_XCNT(b.x)], 1u);
    return b;
}
DI void xcd_barrier_complete(unsigned* bar, unsigned x, unsigned& nloc, unsigned& nx) {
    const unsigned G = gridDim.x * gridDim.y * gridDim.z;
    unsigned sum, cnt, mine, sp = 0u;
    for (;;) {
        sum = 0u; cnt = 0u; mine = 0u;
#pragma unroll
        for (unsigned j = 0; j < 16; ++j) { const unsigned c = xb_ld(&bar[XB_XCNT(j)]); sum += c; cnt += (c > 0u) ? 1u : 0u; mine = (j == x) ? c : mine; }
        if (sum == G) break;
        __builtin_amdgcn_s_sleep(1);
        if ((++sp & 255u) == 0u) { if (xb_ld(&bar[XB_TMO])) break; if (sp > XB_SPIN_CAP) { atomicAdd(&bar[XB_TMO], 1u); break; } }
    }
    nloc = mine > 0u ? mine : 1u; nx = cnt > 0u ? cnt : 1u;
}
DI void xcd_barrier(const XcdBarrier& b) {
    asm volatile("s_waitcnt vmcnt(0)" ::: "memory");
    __syncthreads();
    if (__builtin_amdgcn_workitem_id_x() == 0) {
        unsigned* bar = b.bar;
        __builtin_amdgcn_s_waitcnt(0);
        unsigned nloc = b.st[0], nx = b.st[1];
        if (nloc == 0u) { xcd_barrier_complete(bar, b.x, nloc, nx); b.st[0] = nloc; b.st[1] = nx; }
        const unsigned old = xb_add(&bar[XB_XSUB(b.x)], 1u);
        const unsigned gen = old / nloc;
        if (old + 1u == (gen + 1u) * nloc) {
            __builtin_amdgcn_fence(__ATOMIC_RELEASE, "agent");
            asm volatile("s_waitcnt vmcnt(0)" ::: "memory");
            const unsigned og = xb_add(&bar[XB_TOP], 1u);
            const unsigned tg = og / nx;
            if (og + 1u == (tg + 1u) * nx) xb_add(&bar[XB_TOPGEN], 1u);
            else XB_SPIN(xb_ld(&bar[XB_TOPGEN]) == tg, bar);
            __builtin_amdgcn_fence(__ATOMIC_ACQUIRE, "agent");
            xb_add(&bar[XB_XGEN(b.x)], 1u);
            asm volatile("s_waitcnt vmcnt(0)" ::: "memory");
        } else {
            XB_SPIN(xb_ld(&bar[XB_XGEN(b.x)]) == gen, bar);
            __builtin_amdgcn_fence(__ATOMIC_ACQUIRE, "agent");
            asm volatile("s_waitcnt vmcnt(0)" ::: "memory");
        }
    }
    __syncthreads();
}

constexpr int NPHASE = 2 + 7 * DEPTH;
__global__ void __launch_bounds__(NTHREADS, 2) mega(Args a) {
    extern __shared__ __attribute__((aligned(16))) unsigned char lds_raw[];
    LAS unsigned char* lds = (LAS unsigned char*)lds_raw;
    const int G = gridDim.x, bid = blockIdx.x;
#if !MULTI_LAUNCH
    volatile LAS unsigned* bst = (volatile LAS unsigned*)(lds + LDS_BYTES - 64);
    if (__builtin_amdgcn_workitem_id_x() == 0) { bst[0] = 0u; bst[1] = 0u; }
    __syncthreads();
    (void)xcd_barrier_post((unsigned*)(a.ws + WS_CTL) + 1024, bst);
#endif
    for (int ph = a.lo; ph < a.hi; ++ph) {
        {
        const int tid = ltid(), lane = tid & 63, wave = tid >> 6;
        unsigned char* ws = a.ws; asm volatile("" : "+s"(ws));
        if (ph == 0) { if (PM & 1) phase_prologue(a, lds); }
        else if (ph == NPHASE - 1) { if (PM & 2) for (int row = bid * NWAVES + wave; row < MTOK; row += G * NWAVES) final_row(a, row, lane); }
        else {
            const int l = (ph - 1) / 7, k = (ph - 1) % 7;
            if (k == 0) { if (PM & 4) phase_norm(a, l, lds); }
            else if (k == 1) { if (PM & 8) {
                pg8::Gemm g{(const bf16_t*)(ws + WS_H), (const bf16_t*)(ws + WS_WIN + (size_t)l * SZ_WIN), DM, DM, DM}; pg8::StaticOrder S; S.init(MTOK, NMAIN, G, bid);
                EpiInProj E{(bf16_t*)(ws + WS_PQKV), (bf16_t*)(ws + WS_ZA), (bf16_t*)(ws + WS_AS5), (bf16_t*)(ws + WS_ZB), (bf16_t*)(ws + WS_GT), a.in[19] + (size_t)l * 4096};
                pg8::gemm_phase(lds, g, S, E);
            } } else if (k == 2) {
                if (PM & 32) {
                for (int pu = bid; pu < NB * 32 * NH; pu += G) prep_unit(a, l, pu, lds); }
            } else if (k == 3) {
                const int half = G / 2;
                if (bid < half) { if (PM & 64) for (int su = bid; su < 128; su += half) scan_unit(a, su, lds); }
                else { for (int yu = bid - half; yu < 128; yu += G - half) {
                        { pg8::Gemm g{(const bf16_t*)(ws + WS_AS5), (const bf16_t*)(ws + WS_BTE + (size_t)l * SZ_BTE), KY, KE, KE}; pg8::ListOrder S{yu >> 1, 1 << 30, NG, 0}; EpiE E{(float*)(ws + WS_EBUF)};
                          pg8::gemm_phase(lds, g, S, E); }
                        __syncthreads();
                        s5_carry(a, l, yu >> 1);
                        pg8::Gemm g{(const bf16_t*)(ws + WS_AS5), (const bf16_t*)(ws + WS_BTY + (size_t)l * SZ_BTY), KY, KY, KY}; pg8::ListOrder S{yu, 1 << 30, 128, 1}; EpiY E{(bf16_t*)(ws + WS_YS)};
                        pg8::gemm_phase(lds, g, S, E); __syncthreads(); } }
            } else if (k == 4) {
                if (PM & 256) { pg8::Gemm g{(const bf16_t*)(ws + WS_YS), (const bf16_t*)(ws + WS_WGLU + (size_t)l * SZ_WGLU), WB, WB, WB}; pg8::StaticOrder S; S.init(MTOK, WB, G, bid);
                  EpiGlu E{(const bf16_t*)(ws + WS_YS), (const bf16_t*)(ws + WS_ZB), a.in[16] + (size_t)l * WB, (bf16_t*)(ws + WS_AA)};
                  pg8::gemm_phase(lds, g, S, E); }
                if (PM & 512) {
                const int nglu = (MTOK / 256) * (WB / 256);
                if (G > nglu) { if (bid >= nglu) { const int st = (G - nglu) * NWAVES; for (int row = (bid - nglu) * NWAVES + wave; row < MTOK; row += 2 * st) post_a_rows2(a, l, row, (row + st < MTOK) ? row + st : row, lane); } }
                else { const int st = G * NWAVES; for (int row = bid * NWAVES + wave; row < MTOK; row += 2 * st) post_a_rows2(a, l, row, (row + st < MTOK) ? row + st : row, lane); } }
            } else if (k == 5) { if (PM & 1024) {
                pg8::StaticOrder S; S.init(MTOK, DM, G, bid);
                pg8::Gemm g{(const bf16_t*)(ws + WS_AA), (const bf16_t*)(ws + WS_WPA + (size_t)l * 2 * SZ_WPA), DM, DM, DM}; EpiMergeF E{(const bf16_t*)(ws + WS_GT), (bf16_t*)(ws + WS_MG)}; pg8::gemm_phase(lds, g, S, E);
            } } else { if (PM & 2048) {
                pg8::Gemm g{(const bf16_t*)(ws + WS_MG), (const bf16_t*)(ws + WS_WOUT + (size_t)l * SZ_WOUT), DM, DM, DM}; pg8::StaticOrder S; S.init(MTOK, DM, G, bid);
                EpiOut E{l == 0 ? a.in[0] : (const float*)(ws + WS_X), (float*)(ws + WS_X)};
                pg8::gemm_phase(lds, g, S, E);
            } }
        }
        __syncthreads(); }
#if !MULTI_LAUNCH
        if (ph + 1 < a.hi) { if (ph == a.lo) cg::this_grid().sync(); else { unsigned char* wsb = a.ws; asm volatile("" : "+s"(wsb)); XcdBarrier xb; xb.bar = (unsigned*)(wsb + WS_CTL) + 1024; xb.x = xb_xcc_id(); xb.st = (volatile LAS unsigned*)(lds + LDS_BYTES - 64); xcd_barrier(xb); } }
#endif
    }
}


extern "C" void kernel_launch(void* const* d_in, const int* in_sizes, int n_in, void* d_out, int out_size, void* d_ws, size_t ws_size, hipStream_t stream) {
    static int grid = 0;
    if (grid == 0) {
        int dev = 0, cus = 0, per_cu = 0;
        hipGetDevice(&dev); hipDeviceGetAttribute(&cus, hipDeviceAttributeMultiprocessorCount, dev);
        hipFuncSetAttribute((const void*)mega, hipFuncAttributeMaxDynamicSharedMemorySize, LDS_BYTES);
        hipOccupancyMaxActiveBlocksPerMultiprocessor(&per_cu, (const void*)mega, NTHREADS, LDS_BYTES);
        if (per_cu < 1) { fprintf(stderr, "kernel_launch: occupancy query says %d blocks/CU\n", per_cu); per_cu = 1; }
        grid = cus;
        if (ws_size < WS_END) fprintf(stderr, "kernel_launch: workspace too small: %zu < %zu\n", ws_size, (size_t)WS_END);
        (void)hipGetLastError();
    }
    hipMemsetAsync((char*)d_ws + WS_CTL, 0, 32768, stream);
    Args a{};
    for (int i = 0; i < 22; ++i) a.in[i] = (const float*)d_in[i];
    a.out = (float*)d_out; a.ws = (unsigned char*)d_ws;
#if MULTI_LAUNCH
    for (int ph = 0; ph < NPHASE; ++ph) { a.lo = ph; a.hi = ph + 1; hipLaunchKernelGGL(mega, dim3(grid), dim3(NTHREADS), LDS_BYTES, stream, a); }

#else
    a.lo = 0; a.hi = NPHASE;
    void* args[] = {&a};
    hipError_t e = hipLaunchCooperativeKernel((const void*)mega, dim3(grid), dim3(NTHREADS), args, LDS_BYTES, stream);
    if (e != hipSuccess) fprintf(stderr, "cooperative launch failed: %s (grid %d)\n", hipGetErrorString(e), grid);
#endif
}
```

```cpp
#include <hip/hip_runtime.h>
#include <hip/hip_cooperative_groups.h>
#include <cstdio>
namespace cg = cooperative_groups;


#ifndef PM
#define PM 0xFFFF
#endif
#ifndef MULTI_LAUNCH
#define MULTI_LAUNCH 0
#endif

#define DI __device__ __forceinline__
#define LAS __attribute__((address_space(3)))
typedef unsigned short bf16_t;
typedef short bf16x8 __attribute__((ext_vector_type(8)));
typedef float f32x4 __attribute__((ext_vector_type(4)));
typedef float f32x16 __attribute__((ext_vector_type(16)));
typedef unsigned u32x4 __attribute__((ext_vector_type(4)));
typedef unsigned u32x2 __attribute__((ext_vector_type(2)));

__device__ __forceinline__ int ltid() { int t = __builtin_amdgcn_workitem_id_x(); asm volatile("" : "+v"(t)); return t; }
namespace pg8 {
#define PG8_LAS __attribute__((address_space(3)))
constexpr int BM = 256, BK = 64, HALF = 128, HTB = HALF * BK * 2  , STAGE_BYTES = 8 * HTB, NXCD = 8, WGM = 8;

__host__ __device__ __forceinline__ int lds_byte(int r, int c) { const int st = (r >> 4) * 2 + (c >> 5), rr = r & 15, cc = c & 31, ob = rr * 64 + cc * 2; return st * 1024 + (ob ^ (((ob >> 9) & 1) << 5)); }
__host__ __device__ __forceinline__ void stage_rc(int b, int& R, int& C) { const int st = b / 1024, sb = b % 1024, swz = sb ^ (((sb >> 9) & 1) << 5); R = (st >> 1) * 16 + swz / 64; C = (st & 1) * 32 + (swz % 64) / 2; }
__host__ __device__ __forceinline__ int perm32(int rho) { const int n = rho >> 4, i = rho & 15; return 8 * (i >> 2) + 4 * n + (i & 3); }

struct Unit { int pm, pn; };
struct Gemm { const bf16_t* A; const bf16_t* Bt; int lda, ldb, K; };

struct StaticOrder {
    int nM, nN, nwg, G, c;
    __host__ __device__ void init(int M, int N, int G_, int c_) { nM = M / BM; nN = N / BM; nwg = nM * nN; G = G_; c = c_; }
    __host__ __device__ bool next(int i, Unit& u) const {
        const long L = (long)i * G + c; if (L >= nwg) return false;
        int wgid = (int)L; { const int q = nwg / NXCD, r = nwg % NXCD, xcd = wgid % NXCD, off = wgid / NXCD; wgid = (xcd < r ? xcd * (q + 1) : r * (q + 1) + (xcd - r) * q) + off; }
        const int nig = WGM * nN, gid = wgid / nig, fm = gid * WGM, gsz = (nM - fm) < WGM ? (nM - fm) : WGM;
        u.pm = fm + ((wgid % nig) % gsz); u.pn = (wgid % nig) / gsz; return true;
    }
    __device__ __forceinline__ void a_ready(const Unit&) const {}
    __device__ __forceinline__ void done(const Unit&) const {}
};
struct ListOrder {
    int first, stride, count, mode;
    __device__ __forceinline__ bool next(int i, Unit& u) const { const int idx = first + i * stride; if (idx >= count) return false; if (mode == 0) { u.pm = idx; u.pn = idx; } else { u.pm = idx >> 1; u.pn = idx; } return true; }
    __device__ __forceinline__ void a_ready(const Unit&) const {}
    __device__ __forceinline__ void done(const Unit&) const {}
};
typedef __bf16 bf16x2_t __attribute__((ext_vector_type(2)));
typedef float f32x2_t __attribute__((ext_vector_type(2)));
__device__ __forceinline__ unsigned cvt_pk_bf16(float lo, float hi) { f32x2_t v = {lo, hi}; bf16x2_t b = __builtin_convertvector(v, bf16x2_t); return __builtin_bit_cast(unsigned, b); }

template <class Epi, class Sched>
__device__ __forceinline__ void gemm_phase(PG8_LAS unsigned char* lds, const Gemm g, const Sched& S, const Epi& E) {
    const int tid = ltid(), wid = __builtin_amdgcn_readfirstlane(tid >> 6), lane = tid & 63, wr = wid >> 2, wc = wid & 3, fr = lane & 15, fq = lane >> 4;
    const int K = g.K, nt = K / BK;
    unsigned voffA[2], voffB[2];
#pragma unroll
    for (int i = 0; i < 2; ++i) { int R, C; stage_rc(tid * 16 + i * 8192, R, C); const int Rb = Epi::PERM ? ((R & ~31) + perm32(R & 31)) : R;
        voffA[i] = (unsigned)(R * g.lda + C) * 2u; voffB[i] = (unsigned)(Rb * g.ldb + C) * 2u; }
    const size_t kstep = (size_t)(BK * 2);
    const size_t hstepA = (size_t)HALF * g.lda * 2, hstepB = (size_t)HALF * g.ldb * 2;
    const size_t tstepA = 2 * hstepA, tstepB = 2 * hstepB;
    const unsigned ldsw = (unsigned)wid * 1024u;
    const int aoff = lds_byte(wr * 64 + fr, fq * 8), boff = lds_byte(wc * 32 + fr, fq * 8);
#define PG8_SA(b, h) (((b) * 2 + (h)) * HTB)
#define PG8_SB(b, h) ((4 + (b) * 2 + (h)) * HTB)
#define PG8_STAGE(bufoff, gbase, voff) do { _Pragma("unroll") for (int _i = 0; _i < 2; ++_i) \
        __builtin_amdgcn_global_load_lds((const unsigned*)((const char*)(gbase) + (voff)[_i]), (PG8_LAS unsigned*)(lds + (bufoff) + ldsw + _i * 8192), 16, 0, 0); } while (0)
#define PG8_LDA(dst, b, h) do { _Pragma("unroll") for (int m = 0; m < 4; ++m) _Pragma("unroll") for (int k = 0; k < 2; ++k) dst[m][k] = *(const PG8_LAS bf16x8*)(lds + PG8_SA(b, h) + aoff + m * 2048 + k * 1024); } while (0)
#define PG8_LDB(dst, b, h) do { _Pragma("unroll") for (int n = 0; n < 2; ++n) _Pragma("unroll") for (int k = 0; k < 2; ++k) dst[n][k] = *(const PG8_LAS bf16x8*)(lds + PG8_SB(b, h) + boff + n * 2048 + k * 1024); } while (0)
#define PG8_MMA(ai, bj, At, Bt) do { __builtin_amdgcn_s_setprio(1); _Pragma("unroll") for (int m = 0; m < 4; ++m) _Pragma("unroll") for (int n = 0; n < 2; ++n) _Pragma("unroll") for (int k = 0; k < 2; ++k) \
        acc[ai][bj][m][n] = __builtin_amdgcn_mfma_f32_16x16x32_bf16(Bt[n][k], At[m][k], acc[ai][bj][m][n], 0, 0, 0); __builtin_amdgcn_s_setprio(0); } while (0)
#define PG8_WAIT_V(n) asm volatile("s_waitcnt vmcnt(" #n ")" ::: "memory")
#define PG8_WAIT_L(n) asm volatile("s_waitcnt lgkmcnt(" #n ")" ::: "memory")
#define PG8_BAR __builtin_amdgcn_s_barrier()
#define PG8_SCHED __builtin_amdgcn_sched_barrier(0)
    Unit cur, nxt; int ui = 0;
    if (!S.next(0, cur)) return;
    f32x4 acc[2][2][4][2];
#pragma unroll
    for (int a = 0; a < 2; ++a)
#pragma unroll
        for (int b = 0; b < 2; ++b)
#pragma unroll
            for (int m = 0; m < 4; ++m)
#pragma unroll
                for (int n = 0; n < 2; ++n) acc[a][b][m][n] = (f32x4){0.f, 0.f, 0.f, 0.f};
    bf16x8 At[4][2], B0[2][2], B1[2][2];
    const char* cA = (const char*)g.A + (size_t)cur.pm * tstepA; const char* cB = (const char*)g.Bt + (size_t)cur.pn * tstepB;
    S.a_ready(cur);
    PG8_STAGE(PG8_SB(0, 0), cB, voffB); PG8_STAGE(PG8_SB(0, 1), cB + hstepB, voffB); PG8_STAGE(PG8_SA(0, 0), cA, voffA); PG8_STAGE(PG8_SA(0, 1), cA + hstepA, voffA);
    if (wr == 1) PG8_BAR;
    PG8_WAIT_V(2); PG8_BAR;
    PG8_STAGE(PG8_SB(1, 0), cB + kstep, voffB); PG8_STAGE(PG8_SA(1, 0), cA + kstep, voffA); PG8_STAGE(PG8_SB(1, 1), cB + hstepB + kstep, voffB);
    PG8_WAIT_V(6); PG8_BAR;
    for (;;) {
        const bool has_next = S.next(ui + 1, nxt);
        const char* nA = has_next ? (const char*)g.A + (size_t)nxt.pm * tstepA : cA; const char* nB = has_next ? (const char*)g.Bt + (size_t)nxt.pn * tstepB : cB;
        for (int khalf = 0; khalf < (Epi::HAS_MID ? 2 : 1); ++khalf) {
        const int kt0 = (Epi::HAS_MID && khalf) ? nt / 2 : 0, kt1 = (Epi::HAS_MID && !khalf) ? nt / 2 : nt;
        if constexpr (Epi::HAS_MID) { if (khalf) E.mid(acc, cur, wr, wc, fr, fq); }
        for (int t = kt0; t < kt1; t += 2) {
            const bool last = (t == nt - 2);
            const char* a1 = cA + (size_t)(t + 1) * kstep;
            const char* a2 = last ? nA : cA + (size_t)(t + 2) * kstep; const char* b2 = last ? nB : cB + (size_t)(t + 2) * kstep;
            const char* a3 = a2 + kstep; const char* b3 = b2 + kstep;
            if (last && has_next) S.a_ready(nxt);
            PG8_LDB(B0, 0, 0); PG8_LDB(B1, 0, 1); PG8_SCHED; PG8_LDA(At, 0, 0); PG8_STAGE(PG8_SA(1, 1), a1 + hstepA, voffA);
            PG8_WAIT_V(8); PG8_WAIT_L(0); PG8_BAR; PG8_MMA(0, 0, At, B0); PG8_MMA(0, 1, At, B1); PG8_BAR; PG8_SCHED;
            PG8_LDA(At, 0, 1); PG8_STAGE(PG8_SB(0, 0), b2, voffB); PG8_STAGE(PG8_SB(0, 1), b2 + hstepB, voffB); PG8_STAGE(PG8_SA(0, 0), a2, voffA);
            PG8_WAIT_V(8); PG8_WAIT_L(0); PG8_BAR; PG8_MMA(1, 0, At, B0); PG8_MMA(1, 1, At, B1); PG8_BAR; PG8_SCHED;
            PG8_LDB(B0, 1, 0); PG8_LDB(B1, 1, 1); PG8_SCHED; PG8_LDA(At, 1, 0); PG8_STAGE(PG8_SA(0, 1), a2 + hstepA, voffA);
            PG8_WAIT_V(8); PG8_WAIT_L(0); PG8_BAR; PG8_MMA(0, 0, At, B0); PG8_MMA(0, 1, At, B1); PG8_BAR; PG8_SCHED;
            PG8_LDA(At, 1, 1); PG8_STAGE(PG8_SB(1, 0), b3, voffB); PG8_STAGE(PG8_SB(1, 1), b3 + hstepB, voffB); PG8_STAGE(PG8_SA(1, 0), a3, voffA);
            PG8_WAIT_V(8); PG8_WAIT_L(0); PG8_BAR; PG8_MMA(1, 0, At, B0); PG8_MMA(1, 1, At, B1); PG8_BAR; PG8_SCHED;
        }
        }
        if (wr == 0) PG8_BAR;
        E(acc, cur, wr, wc, fr, fq); S.done(cur);
        if (!has_next) break;
#pragma unroll
        for (int a = 0; a < 2; ++a)
#pragma unroll
            for (int b = 0; b < 2; ++b)
#pragma unroll
                for (int m = 0; m < 4; ++m)
#pragma unroll
                    for (int n = 0; n < 2; ++n) acc[a][b][m][n] = (f32x4){0.f, 0.f, 0.f, 0.f};
        cur = nxt; cA = nA; cB = nB; ++ui;
        if (wr == 1) PG8_BAR;
    }
    PG8_WAIT_V(0);
    PG8_BAR;
#undef PG8_SA
#undef PG8_SB
#undef PG8_STAGE
#undef PG8_LDA
#undef PG8_LDB
#undef PG8_MMA
#undef PG8_WAIT_V
#undef PG8_WAIT_L
#undef PG8_BAR
#undef PG8_SCHED
}
}

constexpr int DM = 2048, NB = 4, SEQ = 2048, MTOK = NB * SEQ, DEPTH = 4;
constexpr int NH = 8, HD = 128, WA = 1024, WB = 1024, NG = 64, NP = 64, PROJ = 10272, NMAIN = 10240;
constexpr int TS5 = 32;
constexpr int KY = 768, KE = 512;
constexpr float RMS_EPS = 1e-6f;
constexpr int NTHREADS = 512, NWAVES = 8;
constexpr int LDS_BYTES = 147456;

constexpr size_t MiB = 1u << 20;
constexpr size_t alignup(size_t x) { return (x + 255) & ~(size_t)255; }
constexpr size_t WS_CTL = 0;
constexpr size_t SZ_WIN = (size_t)NMAIN * DM * 2, SZ_WBA = (size_t)32 * DM * 2, SZ_WGLU = (size_t)WB * WB * 2, SZ_WPA = (size_t)DM * WA * 2, SZ_WPB = (size_t)DM * WB * 2, SZ_WOUT = (size_t)DM * DM * 2;
constexpr size_t SZ_BTE = (size_t)NG * 256 * KE * 2, SZ_BTY = (size_t)NG * 512 * KY * 2;
constexpr size_t WS_EGP = 65536;
constexpr size_t WS_WIN = 1 * MiB;
constexpr size_t WS_WBA = WS_WIN + DEPTH * SZ_WIN;
constexpr size_t WS_WGLU = WS_WBA + DEPTH * SZ_WBA;
constexpr size_t WS_WPA = WS_WGLU + DEPTH * SZ_WGLU;
constexpr size_t WS_WPB = WS_WPA + DEPTH * SZ_WPA;
constexpr size_t WS_WOUT = WS_WPB + DEPTH * SZ_WPB;
constexpr size_t WS_BTE = WS_WOUT + DEPTH * SZ_WOUT;
constexpr size_t WS_BTY = WS_BTE + DEPTH * SZ_BTE;
constexpr size_t WS_X = WS_BTY + DEPTH * SZ_BTY;
constexpr size_t WS_H = WS_X + (size_t)MTOK * DM * 4;
constexpr size_t WS_BA = WS_H + (size_t)MTOK * DM * 2;
constexpr size_t WS_PQKV = WS_BA + (size_t)MTOK * 32 * 4;
constexpr size_t WS_ZA = WS_PQKV + (size_t)MTOK * 3072 * 2;
constexpr size_t WS_AS5 = WS_ZA + (size_t)MTOK * 1024 * 2;
constexpr size_t WS_ZB = WS_AS5 + (size_t)NG * 256 * KY * 2;
constexpr size_t WS_GT = WS_ZB + (size_t)MTOK * 1024 * 2;
constexpr size_t WS_EBUF = WS_GT + (size_t)MTOK * 4096 * 2;
constexpr size_t WS_YS = WS_EBUF + (size_t)NG * 256 * 256 * 4;
constexpr size_t WS_EG = WS_YS + (size_t)MTOK * 1024 * 2;
constexpr size_t WS_OF = WS_EG + 65536;
constexpr size_t WS_AA = WS_OF + (size_t)2 * MTOK * 1024 * 4;
constexpr size_t WS_AB = WS_AA + (size_t)MTOK * 1024 * 2;
constexpr size_t REC_BYTES = 73728;
constexpr size_t WS_REC = WS_AB + (size_t)MTOK * 1024 * 2;
constexpr size_t WS_TMP = WS_REC;
constexpr size_t WS_MG = WS_REC + (size_t)MTOK * DM * 4;
constexpr size_t WS_END = WS_REC + (size_t)4096 * REC_BYTES;
static_assert((size_t)MTOK * DM * 6 <= (size_t)4096 * REC_BYTES, "overlay");

struct Args { const float* in[22]; float* out; unsigned char* ws; int lo, hi, flags, pad; };

DI float bf2f(unsigned short b) { return __uint_as_float(((unsigned)b) << 16); }
DI unsigned pk2(float lo, float hi) { return pg8::cvt_pk_bf16(lo, hi); }
DI float sigmoidf_(float x) { return __builtin_amdgcn_rcpf(1.0f + __expf(-x)); }
DI float siluf_(float x) { return x * __builtin_amdgcn_rcpf(1.0f + __expf(-x)); }
DI float geluf_(float x) { return x * __builtin_amdgcn_rcpf(1.0f + __expf(-1.5957691216057308f * (x + 0.044715f * x * x * x))); }
DI void unpack8(const u32x4 v, float (&f)[8]) {
    f[0] = __uint_as_float(v.x << 16); f[1] = __uint_as_float(v.x & 0xffff0000u); f[2] = __uint_as_float(v.y << 16); f[3] = __uint_as_float(v.y & 0xffff0000u);
    f[4] = __uint_as_float(v.z << 16); f[5] = __uint_as_float(v.z & 0xffff0000u); f[6] = __uint_as_float(v.w << 16); f[7] = __uint_as_float(v.w & 0xffff0000u); }
DI u32x4 pack8(const float (&f)[8]) { u32x4 w; w.x = pk2(f[0], f[1]); w.y = pk2(f[2], f[3]); w.z = pk2(f[4], f[5]); w.w = pk2(f[6], f[7]); return w; }
DI float wave_sum(float v) {
#pragma unroll
    for (int o = 1; o < 64; o <<= 1) v += __shfl_xor(v, o);
    return v; }
#define MFMA32(a, b, c) __builtin_amdgcn_mfma_f32_32x32x16_bf16((a), (b), (c), 0, 0, 0)
DI int crow(int reg, int h) { return (reg & 3) + 8 * (reg >> 2) + 4 * h; }
#define LDS_WAIT() asm volatile("s_waitcnt lgkmcnt(0)" ::: "memory")
#define LBAR() do { asm volatile("s_waitcnt lgkmcnt(0)" ::: "memory"); __builtin_amdgcn_s_barrier(); asm volatile("" ::: "memory"); } while (0)

using pg8::Unit;
struct EpiInProj {
    static constexpr bool PERM = true, HAS_MID = false;
    bf16_t *pqkv, *za, *as5, *zb, *gt; const float* bgate;
    DI void operator()(const f32x4 (&acc)[2][2][4][2], const Unit& u, int wr, int wc, int fr, int fq) const {
        const int row0 = u.pm * 256 + wr * 64 + fr, colt = u.pn * 256;
#pragma unroll
        for (int ai = 0; ai < 2; ++ai)
#pragma unroll
            for (int m = 0; m < 4; ++m) { const int row = row0 + ai * 128 + m * 16;
#pragma unroll
                for (int bj = 0; bj < 2; ++bj) { const int col = colt + bj * 128 + wc * 32 + 8 * fq;
                    f32x4 v0 = acc[ai][bj][m][0], v1 = acc[ai][bj][m][1]; bf16_t* dst;
                    if (colt < 3072) dst = pqkv + (size_t)row * 3072 + col;
                    else if (colt < 4096) dst = za + (size_t)row * 1024 + (col - 3072);
                    else if (colt < 5120) { const int ch = col - 4096, g = ch >> 4, cp = ch & 15, n = row >> 5, s = row & 31; dst = as5 + ((size_t)(g * 256 + n) * KY + s * 16 + cp); }
                    else if (colt < 6144) dst = zb + (size_t)row * 1024 + (col - 5120);
                    else { const int gc = col - 6144; const f32x4 b0 = *(const f32x4*)(bgate + gc), b1 = *(const f32x4*)(bgate + gc + 4);
#pragma unroll
                        for (int j = 0; j < 4; ++j) { v0[j] = sigmoidf_(v0[j] + b0[j]); v1[j] = sigmoidf_(v1[j] + b1[j]); }
                        dst = gt + (size_t)row * 4096 + gc; }
                    u32x4 w; w.x = pk2(v0[0], v0[1]); w.y = pk2(v0[2], v0[3]); w.z = pk2(v1[0], v1[1]); w.w = pk2(v1[2], v1[3]);
                    *(u32x4*)dst = w; } }
    }
};
struct EpiE {
    static constexpr bool PERM = false, HAS_MID = false;
    float* E;
    DI void operator()(const f32x4 (&acc)[2][2][4][2], const Unit& u, int wr, int wc, int fr, int fq) const {
        float* base = E + (size_t)u.pm * 256 * 256;
#pragma unroll
        for (int ai = 0; ai < 2; ++ai)
#pragma unroll
            for (int m = 0; m < 4; ++m) { float* rowp = base + (size_t)(ai * 128 + wr * 64 + m * 16 + fr) * 256 + wc * 32 + 4 * fq;
#pragma unroll
                for (int bj = 0; bj < 2; ++bj)
#pragma unroll
                    for (int n = 0; n < 2; ++n) *(f32x4*)(rowp + bj * 128 + n * 16) = acc[ai][bj][m][n]; }
    }
};
struct EpiY {
    static constexpr bool PERM = true, HAS_MID = false;
    bf16_t* ys;
    DI void operator()(const f32x4 (&acc)[2][2][4][2], const Unit& u, int wr, int wc, int fr, int fq) const {
        const int g = u.pm, nt = u.pn & 1;
#pragma unroll
        for (int ai = 0; ai < 2; ++ai)
#pragma unroll
            for (int m = 0; m < 4; ++m) { const int n = ai * 128 + wr * 64 + m * 16 + fr;
#pragma unroll
                for (int bj = 0; bj < 2; ++bj) { const int cc = nt * 256 + bj * 128 + wc * 32 + 8 * fq, t = cc >> 4, c = cc & 15;
                    const f32x4 v0 = acc[ai][bj][m][0], v1 = acc[ai][bj][m][1];
                    float f[8] = {geluf_(v0[0]), geluf_(v0[1]), geluf_(v0[2]), geluf_(v0[3]), geluf_(v1[0]), geluf_(v1[1]), geluf_(v1[2]), geluf_(v1[3])};
                    *(u32x4*)(ys + ((size_t)(n * TS5 + t) * 1024 + g * 16 + c)) = pack8(f); } }
    }
};
struct EpiGlu {
    static constexpr bool PERM = true, HAS_MID = false;
    const bf16_t *ys, *zb; const float* bglu; bf16_t* ab;
    DI void operator()(const f32x4 (&acc)[2][2][4][2], const Unit& u, int wr, int wc, int fr, int fq) const {
        const int row0 = u.pm * 256 + wr * 64 + fr, colb = u.pn * 256 + wc * 32 + 8 * fq;
        f32x4 bb[2][2];
#pragma unroll
        for (int bj = 0; bj < 2; ++bj) { bb[bj][0] = *(const f32x4*)(bglu + colb + bj * 128); bb[bj][1] = *(const f32x4*)(bglu + colb + bj * 128 + 4); }
#pragma unroll
        for (int ai = 0; ai < 2; ++ai)
#pragma unroll
          for (int mp = 0; mp < 2; ++mp) { u32x4 yv[2][2], zv[2][2];
#pragma unroll
            for (int mm = 0; mm < 2; ++mm)
#pragma unroll
                for (int bj = 0; bj < 2; ++bj) { const size_t off = (size_t)(row0 + ai * 128 + (mp * 2 + mm) * 16) * 1024 + colb + bj * 128; yv[mm][bj] = *(const u32x4*)(ys + off); zv[mm][bj] = *(const u32x4*)(zb + off); }
#pragma unroll
            for (int mm = 0; mm < 2; ++mm)
#pragma unroll
                for (int bj = 0; bj < 2; ++bj) { const int m = mp * 2 + mm; const size_t off = (size_t)(row0 + ai * 128 + m * 16) * 1024 + colb + bj * 128;
                    const f32x4 v0 = acc[ai][bj][m][0], v1 = acc[ai][bj][m][1]; float y[8], z[8], o[8]; unpack8(yv[mm][bj], y); unpack8(zv[mm][bj], z);
#pragma unroll
                    for (int j = 0; j < 4; ++j) { o[j] = y[j] * sigmoidf_(v0[j] + bb[bj][0][j]) * siluf_(z[j]); o[4 + j] = y[4 + j] * sigmoidf_(v1[j] + bb[bj][1][j]) * siluf_(z[4 + j]); }
                    *(u32x4*)(ab + (size_t)(row0 + ai * 128 + m * 16) * 2048 + 1024 + colb + bj * 128) = pack8(o); } }
    }
};
struct EpiMergeF {
    static constexpr bool PERM = true, HAS_MID = true;
    const bf16_t* gt; bf16_t* mg;
    DI void mid(f32x4 (&acc)[2][2][4][2], const Unit& u, int wr, int wc, int fr, int fq) const {
        int row0 = u.pm * 256 + wr * 64 + fr, colb = u.pn * 256 + wc * 32 + 8 * fq; asm volatile("" : "+v"(row0), "+v"(colb));
#pragma unroll
        for (int ai = 0; ai < 2; ++ai)
#pragma unroll
            for (int mp = 0; mp < 2; ++mp) { u32x4 ga[2][2], gb[2][2];
#pragma unroll
                for (int mm = 0; mm < 2; ++mm)
#pragma unroll
                    for (int bj = 0; bj < 2; ++bj) { const bf16_t* gp = gt + (size_t)(row0 + ai * 128 + (mp * 2 + mm) * 16) * 4096 + colb + bj * 128; ga[mm][bj] = *(const u32x4*)gp; gb[mm][bj] = *(const u32x4*)(gp + 2048); }
#pragma unroll
                for (int mm = 0; mm < 2; ++mm)
#pragma unroll
                    for (int bj = 0; bj < 2; ++bj) { const int m = mp * 2 + mm; float a8[8], b8[8]; unpack8(ga[mm][bj], a8); unpack8(gb[mm][bj], b8);
#pragma unroll
                        for (int j = 0; j < 4; ++j) { acc[ai][bj][m][0][j] *= a8[j] * __builtin_amdgcn_rcpf(fmaxf(b8[j], 1e-30f)); acc[ai][bj][m][1][j] *= a8[4 + j] * __builtin_amdgcn_rcpf(fmaxf(b8[4 + j], 1e-30f)); } }
                asm volatile("" ::: "memory"); }
    }
    DI void operator()(const f32x4 (&acc)[2][2][4][2], const Unit& u, int wr, int wc, int fr, int fq) const {
        int row0 = u.pm * 256 + wr * 64 + fr, colb = u.pn * 256 + wc * 32 + 8 * fq; asm volatile("" : "+v"(row0), "+v"(colb));
#pragma unroll
        for (int ai = 0; ai < 2; ++ai) { u32x4 gb[4][2];
#pragma unroll
            for (int m = 0; m < 4; ++m)
#pragma unroll
                for (int bj = 0; bj < 2; ++bj) gb[m][bj] = *(const u32x4*)(gt + (size_t)(row0 + ai * 128 + m * 16) * 4096 + 2048 + colb + bj * 128);
#pragma unroll
            for (int m = 0; m < 4; ++m)
#pragma unroll
                for (int bj = 0; bj < 2; ++bj) { float b8[8], o[8]; unpack8(gb[m][bj], b8); const f32x4 v0 = acc[ai][bj][m][0], v1 = acc[ai][bj][m][1];
#pragma unroll
                    for (int j = 0; j < 4; ++j) { o[j] = b8[j] * v0[j]; o[4 + j] = b8[4 + j] * v1[j]; }
                    *(u32x4*)(mg + (size_t)(row0 + ai * 128 + m * 16) * 2048 + colb + bj * 128) = pack8(o); } }
    }
};
struct EpiOut {
    static constexpr bool PERM = false, HAS_MID = false;
    const float* xi; float* xo;
    DI void operator()(const f32x4 (&acc)[2][2][4][2], const Unit& u, int wr, int wc, int fr, int fq) const {
        const int row0 = u.pm * 256 + wr * 64 + fr, col0 = u.pn * 256 + wc * 32 + 4 * fq;
#pragma unroll
        for (int ai = 0; ai < 2; ++ai)
#pragma unroll
            for (int mp = 0; mp < 2; ++mp) { f32x4 rv[2][2][2];
#pragma unroll
                for (int mm = 0; mm < 2; ++mm)
#pragma unroll
                    for (int bj = 0; bj < 2; ++bj)
#pragma unroll
                        for (int n = 0; n < 2; ++n) rv[mm][bj][n] = *(const f32x4*)(xi + (size_t)(row0 + ai * 128 + (mp * 2 + mm) * 16) * DM + col0 + bj * 128 + n * 16);
#pragma unroll
                for (int mm = 0; mm < 2; ++mm)
#pragma unroll
                    for (int bj = 0; bj < 2; ++bj)
#pragma unroll
                        for (int n = 0; n < 2; ++n) *(f32x4*)(xo + (size_t)(row0 + ai * 128 + (mp * 2 + mm) * 16) * DM + col0 + bj * 128 + n * 16) = rv[mm][bj][n] + acc[ai][bj][mp * 2 + mm][n]; }
    }
};

DI void tr_item(const float* W, int N, int k0, int n0, bf16_t* dst, int Kp, LAS float* scr, int lane) {
    float wv[32];
#pragma unroll
    for (int i = 0; i < 32; ++i) { const int kk = 2 * i + (lane >> 5); wv[i] = W[(size_t)(k0 + kk) * N + n0 + (lane & 31)]; }
#pragma unroll
    for (int i = 0; i < 32; ++i) { const int kk = 2 * i + (lane >> 5); scr[kk * 33 + (lane & 31)] = wv[i]; }
    LDS_WAIT(); asm volatile("" ::: "memory");
    const int c = lane & 7;
#pragma unroll
    for (int j = 0; j < 4; ++j) { const int n = (lane >> 3) + 8 * j; const LAS float* s = scr + (8 * c) * 33 + n;
        u32x4 o; o.x = pk2(s[0 * 33], s[1 * 33]); o.y = pk2(s[2 * 33], s[3 * 33]); o.z = pk2(s[4 * 33], s[5 * 33]); o.w = pk2(s[6 * 33], s[7 * 33]);
        *(u32x4*)(dst + (size_t)n * Kp + k0 + 8 * c) = o; }
    LDS_WAIT(); asm volatile("" ::: "memory");
}

DI void s5_prep(const Args& a, int l, int g, LAS unsigned char* lds) {
    const int tid = ltid();
    LAS float* POWr = (LAS float*)lds;
    LAS float* POWi = POWr + 4224;
    LAS float* BBr = POWi + 4224;
    LAS float* BBi = BBr + 2048;
    LAS float* CCr = BBi + 2048;
    LAS float* CCi = CCr + 2048;
    LAS float* KK = CCi + 2048;
    const float *lam_re = a.in[7], *lam_im = a.in[8], *log_dt = a.in[9], *b_re = a.in[10], *b_im = a.in[11], *c_re = a.in[12], *c_im = a.in[13], *d_skip = a.in[14];
    if (tid < 128) {
        const int d = tid >> 6, p = tid & 63; const int idx = ((l * 2 + d) * NG + g) * NP + p;
        const float lr = lam_re[idx], li = lam_im[idx], dt = expf(log_dt[(l * 2 + d) * NG + g]);
        const double rev1 = (double)li * (double)dt * 0.15915494309189535;
        for (int k = 0; k <= 32; ++k) { double rv = rev1 * (double)k; rv -= rint(rv); const float rvf = (float)rv;
            const float e = expf((float)k * lr * dt), s = __builtin_amdgcn_sinf(rvf), c = __builtin_amdgcn_cosf(rvf);
            POWr[(d * 33 + k) * 64 + p] = e * c; POWi[(d * 33 + k) * 64 + p] = e * s; }
        double r1 = rev1; r1 -= rint(r1); double rh = rev1 * 0.5; rh -= rint(rh);
        const float em1 = expm1f(lr * dt), s1 = __builtin_amdgcn_sinf((float)r1), c1 = __builtin_amdgcn_cosf((float)r1), sh = __builtin_amdgcn_sinf((float)rh);
        const float cm1 = -2.f * sh * sh;
        const float nr = em1 * c1 + cm1, ni = (em1 + 1.f) * s1;
        const float den = lr * lr + li * li; const float cr = (nr * lr + ni * li) / den, ci = (ni * lr - nr * li) / den;
        for (int cp = 0; cp < 16; ++cp) { const float br = b_re[(size_t)idx * 16 + cp], bi = b_im[(size_t)idx * 16 + cp];
            BBr[(d * 64 + p) * 16 + cp] = cr * br - ci * bi; BBi[(d * 64 + p) * 16 + cp] = cr * bi + ci * br; }
    }
    for (int i = tid; i < 2048; i += NTHREADS) { const int d = i >> 10, c = (i >> 6) & 15, p = i & 63; const size_t cidx = ((size_t)((l * 2 + d) * NG + g) * 16 + c) * 64 + p; CCr[i] = c_re[cidx]; CCi[i] = c_im[cidx]; }
    __syncthreads();
    { const int d = tid >> 8, c = (tid >> 4) & 15, cp = tid & 15; const int lane = tid & 63, gbase = lane & 48;
      float bbr[64], bbi[64];
#pragma unroll
      for (int p = 0; p < 64; ++p) { bbr[p] = BBr[(d * 64 + p) * 16 + cp]; bbi[p] = BBi[(d * 64 + p) * 16 + cp]; }
      float ccr[4], cci[4];
#pragma unroll
      for (int q = 0; q < 4; ++q) { ccr[q] = CCr[(d * 16 + c) * 64 + cp * 4 + q]; cci[q] = CCi[(d * 16 + c) * 64 + cp * 4 + q]; }
      for (int k = 0; k < 32; ++k) { float zr[4], zi[4];
#pragma unroll
          for (int q = 0; q < 4; ++q) { const float pr = POWr[(d * 33 + k) * 64 + cp * 4 + q], pi = POWi[(d * 33 + k) * 64 + cp * 4 + q]; zr[q] = ccr[q] * pr - cci[q] * pi; zi[q] = ccr[q] * pi + cci[q] * pr; }
          float s = 0.f;
#pragma unroll
          for (int p = 0; p < 64; ++p) { const float ar = __shfl(zr[p & 3], gbase + (p >> 2)), ai = __shfl(zi[p & 3], gbase + (p >> 2)); s += ar * bbr[p] - ai * bbi[p]; }
          KK[(d * 32 + k) * 256 + c * 16 + cp] = s; } }
    __syncthreads();
    bf16_t* bty = (bf16_t*)(a.ws + WS_BTY + (size_t)l * SZ_BTY) + (size_t)g * 512 * KY;
    for (int ch = tid; ch < 512 * 96; ch += NTHREADS) { const int row = ch / 96, kk0 = (ch % 96) * 8, t = row >> 4, c = row & 15; float v[8];
        if (kk0 < 512) { const int s = kk0 >> 4, cp0 = kk0 & 15;
#pragma unroll
            for (int e = 0; e < 8; ++e) { const int cp = cp0 + e; float x;
                if (s < t) x = KK[(0 * 32 + (t - s)) * 256 + c * 16 + cp];
                else if (s > t) x = KK[(1 * 32 + (s - t)) * 256 + c * 16 + cp];
                else x = KK[c * 16 + cp] + KK[32 * 256 + c * 16 + cp] + (c == cp ? d_skip[l * WB + g * 16 + c] : 0.f);
                v[e] = x; } }
        else { const int d = kk0 < 640 ? 0 : 1, f = kk0 - 512 - d * 128, ri = f >> 6, p0 = f & 63, k = d ? (32 - t) : (t + 1);
#pragma unroll
            for (int e = 0; e < 8; ++e) { const int p = p0 + e; const float cr = CCr[(d * 16 + c) * 64 + p], ci = CCi[(d * 16 + c) * 64 + p], pr = POWr[(d * 33 + k) * 64 + p], pi = POWi[(d * 33 + k) * 64 + p];
                v[e] = ri ? -(cr * pi + ci * pr) : (cr * pr - ci * pi); } }
        *(u32x4*)(bty + (size_t)row * KY + kk0) = pack8(v); }
    bf16_t* bte = (bf16_t*)(a.ws + WS_BTE + (size_t)l * SZ_BTE) + (size_t)g * 256 * KE;
    for (int ch = tid; ch < 256 * 64; ch += NTHREADS) { const int row = ch >> 6, kk0 = (ch & 63) * 8, d = row >> 7, ri = (row >> 6) & 1, p = row & 63, s = kk0 >> 4, cp0 = kk0 & 15, k = d ? s : (31 - s);
        const float pr = POWr[(d * 33 + k) * 64 + p], pi = POWi[(d * 33 + k) * 64 + p]; float v[8];
#pragma unroll
        for (int e = 0; e < 8; ++e) { const float br = BBr[(d * 64 + p) * 16 + cp0 + e], bi = BBi[(d * 64 + p) * 16 + cp0 + e]; v[e] = ri ? (pr * bi + pi * br) : (pr * br - pi * bi); }
        *(u32x4*)(bte + (size_t)row * KE + kk0) = pack8(v); }
    __syncthreads();
}

struct TrTile { const float* W; bf16_t* dst; int N, Kp; };
DI bool tr_decode(const Args& a, int it, TrTile& t) {
    constexpr int T0 = 32 * 40, T1 = 16 * 4, T2 = 16 * 8, T3 = 16 * 8, T4 = 32 * 8, TL = T0 + T1 + T2 + T3 + T4;
    if (it >= DEPTH * TL) return false;
    const int l = it / TL; int r = it % TL;
    if (r < T0) { const int kb = r / 40, tt = r % 40, n0 = tt < 16 ? tt * 256 : 4128 + (tt - 16) * 256;
        t.W = a.in[2] + (size_t)l * DM * PROJ + (size_t)(kb * 64) * PROJ + n0; t.N = PROJ; t.Kp = DM; t.dst = (bf16_t*)(a.ws + WS_WIN + (size_t)l * SZ_WIN) + (size_t)(tt * 256) * DM + kb * 64; return true; } r -= T0;
    if (r < T1) { const int kb = r / 4, tt = r % 4; t.W = a.in[15] + (size_t)l * WB * WB + (size_t)(kb * 64) * WB + tt * 256; t.N = WB; t.Kp = WB; t.dst = (bf16_t*)(a.ws + WS_WGLU + (size_t)l * SZ_WGLU) + (size_t)(tt * 256) * WB + kb * 64; return true; } r -= T1;
    if (r < T2) { const int kb = r / 8, tt = r % 8; t.W = a.in[17] + (size_t)l * WA * DM + (size_t)(kb * 64) * DM + tt * 256; t.N = DM; t.Kp = 2048; t.dst = (bf16_t*)(a.ws + WS_WPA + (size_t)l * 2 * SZ_WPA) + (size_t)(tt * 256) * 2048 + kb * 64; return true; } r -= T2;
    if (r < T3) { const int kb = r / 8, tt = r % 8; t.W = a.in[18] + (size_t)l * WB * DM + (size_t)(kb * 64) * DM + tt * 256; t.N = DM; t.Kp = 2048; t.dst = (bf16_t*)(a.ws + WS_WPA + (size_t)l * 2 * SZ_WPA) + (size_t)(tt * 256) * 2048 + 1024 + kb * 64; return true; } r -= T3;
    { const int kb = r / 8, tt = r % 8; t.W = a.in[20] + (size_t)l * DM * DM + (size_t)(kb * 64) * DM + tt * 256; t.N = DM; t.Kp = DM; t.dst = (bf16_t*)(a.ws + WS_WOUT + (size_t)l * SZ_WOUT) + (size_t)(tt * 256) * DM + kb * 64; return true; }
}
DI void phase_prologue(const Args& a, LAS unsigned char* lds) {
    const int tid = ltid(), lane = tid & 63, wave = tid >> 6, G = gridDim.x;
    const bool s5_last = ((blockIdx.x >> 3) & 1) != 0;
    if (!s5_last) { for (int it = blockIdx.x; it < DEPTH * NG; it += G) s5_prep(a, it >> 6, it & 63, lds); }
    __syncthreads();
    { LAS float* scr = (LAS float*)(lds + wave * 8448); const int gw = blockIdx.x * NWAVES + wave, NGW = G * NWAVES;
      for (int it = gw; it < DEPTH * 32; it += NGW) { const int l = it >> 5, kb = it & 31;
          tr_item(a.in[2] + (size_t)l * DM * PROJ, PROJ, kb * 64, 4096, (bf16_t*)(a.ws + WS_WBA + (size_t)l * SZ_WBA), DM, scr, lane); } }
    __syncthreads();
    LAS float* T = (LAS float*)lds;
    TrTile cur; int it = blockIdx.x; bool have = tr_decode(a, it, cur);
    f32x4 v[8];
    if (have) {
#pragma unroll
        for (int i = 0; i < 8; ++i) v[i] = *(const f32x4*)(cur.W + (size_t)(wave * 8 + i) * cur.N + 4 * lane); }
    while (have) {
#pragma unroll
        for (int i = 0; i < 8; ++i) *(LAS f32x4*)(T + (wave * 8 + i) * 260 + 4 * (lane ^ wave)) = v[i];
        LBAR();
        TrTile nxt; const bool hn = tr_decode(a, it + G, nxt);
        if (hn) {
#pragma unroll
            for (int i = 0; i < 8; ++i) v[i] = *(const f32x4*)(nxt.W + (size_t)(wave * 8 + i) * nxt.N + 4 * lane); }
#pragma unroll
        for (int p = 0; p < 4; ++p) { const int task = tid + 512 * p, n = task >> 3, c = task & 7; const LAS float* sp = T + (8 * c) * 260 + 4 * ((n >> 2) ^ c) + (n & 3);
            u32x4 o; o.x = pk2(sp[0 * 260], sp[1 * 260]); o.y = pk2(sp[2 * 260], sp[3 * 260]); o.z = pk2(sp[4 * 260], sp[5 * 260]); o.w = pk2(sp[6 * 260], sp[7 * 260]);
            *(u32x4*)(cur.dst + (size_t)n * cur.Kp + 8 * c) = o; }
        LBAR();
        cur = nxt; have = hn; it += G;
    }
    if (s5_last) { __syncthreads(); for (int it2 = blockIdx.x; it2 < DEPTH * NG; it2 += G) s5_prep(a, it2 >> 6, it2 & 63, lds); }
}

DI void phase_norm(const Args& a, int l, LAS unsigned char* lds) {
    const int tid = ltid(), lane = tid & 63, wave = tid >> 6, G = gridDim.x;
    const float* xin = l == 0 ? a.in[0] : (const float*)(a.ws + WS_X);
    const float* lng = a.in[1] + (size_t)l * DM;
    bf16_t* H = (bf16_t*)(a.ws + WS_H);
    const bf16_t* wba = (const bf16_t*)(a.ws + WS_WBA + (size_t)l * SZ_WBA);
    float* BA = (float*)(a.ws + WS_BA);
    for (int rg = blockIdx.x; rg < MTOK / 32; rg += G) {
        for (int rr = 0; rr < 4; ++rr) { const int row = rg * 32 + wave * 4 + rr;
            const f32x4* xr = (const f32x4*)(xin + (size_t)row * DM) + lane; f32x4 v[8]; float s = 0.f;
#pragma unroll
            for (int j = 0; j < 8; ++j) { v[j] = xr[64 * j]; s += (v[j].x * v[j].x + v[j].y * v[j].y) + (v[j].z * v[j].z + v[j].w * v[j].w); }
            const float rstd = rsqrtf(wave_sum(s) * (1.f / DM) + RMS_EPS);
            u32x2* o8 = (u32x2*)(H + (size_t)row * DM) + lane;
#pragma unroll
            for (int j = 0; j < 8; ++j) { const f32x4 gg = ((const f32x4*)lng)[lane + 64 * j]; u32x2 w; w.x = pk2(v[j].x * rstd * gg.x, v[j].y * rstd * gg.y); w.y = pk2(v[j].z * rstd * gg.z, v[j].w * rstd * gg.w); o8[64 * j] = w; }
        }
        __syncthreads();
        { const int r = lane & 31, hh = lane >> 5; f32x16 acc;
#pragma unroll
          for (int i = 0; i < 16; ++i) acc[i] = 0.f;
          const bf16_t* ap = H + (size_t)(rg * 32 + r) * DM + wave * 256 + 8 * hh; const bf16_t* bp = wba + (size_t)r * DM + wave * 256 + 8 * hh;
          bf16x8 afr[16], bfr[16];
#pragma unroll
          for (int i = 0; i < 16; ++i) { afr[i] = *(const bf16x8*)(ap + 16 * i); bfr[i] = *(const bf16x8*)(bp + 16 * i); }
#pragma unroll
          for (int i = 0; i < 16; ++i) acc = MFMA32(afr[i], bfr[i], acc);
          LAS float* red = (LAS float*)lds + wave * 1024;
#pragma unroll
          for (int i = 0; i < 16; ++i) red[crow(i, hh) * 32 + r] = acc[i];
        }
        __syncthreads();
        for (int o = tid; o < 1024; o += NTHREADS) { float s = 0.f;
#pragma unroll
            for (int w = 0; w < 8; ++w) s += ((LAS float*)lds)[w * 1024 + o];
            BA[(size_t)(rg * 32 + (o >> 5)) * 32 + (o & 31)] = s; }
        __syncthreads();
    }
}

DI bf16_t* rec_ptr(const Args& a, int b, int h, int dir, int j) { return (bf16_t*)(a.ws + WS_REC + (size_t)(((b * NH + h) * 2 + dir) * 32 + j) * REC_BYTES); }
constexpr int REC_W = 0, REC_U = 8192, REC_QG = 16384, REC_KDT = 24576, REC_QK = 32768;


template <int DIR>
DI void solve_T(const LAS float* LM, const LAS float* SM, LAS unsigned short* AMv, LAS unsigned short* AMw, int cp) {
    const LAS float* Lm = LM + DIR * 4096;
    const int c = DIR ? 63 - cp : cp; const float sv = SM[DIR * 64 + c], sw = sv * SM[256 + DIR * 64 + c];
    LAS unsigned short* ov = AMv + c; LAS unsigned short* ow = AMw + c;
    typedef float f32x2p __attribute__((ext_vector_type(2)));
    f32x2p xs[32];
#pragma unroll
    for (int q = 0; q < 32; ++q) xs[q] = (f32x2p){0.f, 0.f};
    f32x4 cur[16], nxt[16];
#pragma unroll
    for (int q = 0; q < 16; ++q) { cur[q] = (f32x4){0.f, 0.f, 0.f, 0.f}; nxt[q] = (f32x4){0.f, 0.f, 0.f, 0.f}; }
#pragma unroll
    for (int rp = 0; rp < 64; ++rp) { const int r = DIR ? 63 - rp : rp;
        asm volatile("" ::: "memory");
        if (rp + 1 < 64) {
#pragma unroll
            for (int s4 = 0; s4 < (rp + 1 + 3) / 4; ++s4) nxt[s4] = *(const LAS f32x4*)(Lm + (rp + 1) * 64 + 4 * s4); }
        float bv = (rp == cp) ? 1.f : 0.f;
        f32x2p pa[2] = {(f32x2p){0.f, 0.f}, (f32x2p){0.f, 0.f}}, pb[2] = {(f32x2p){0.f, 0.f}, (f32x2p){0.f, 0.f}};
#pragma unroll
        for (int s4 = 0; s4 < (rp + 3) / 4; ++s4) { const f32x2p la = (f32x2p){cur[s4].x, cur[s4].y}, lb = (f32x2p){cur[s4].z, cur[s4].w};
            pa[s4 & 1] += la * xs[2 * s4]; pb[s4 & 1] += lb * xs[2 * s4 + 1]; }
        const f32x2p pt = (pa[0] + pa[1]) + (pb[0] + pb[1]);
        bv -= pt.x + pt.y;
        if (rp & 1) xs[rp >> 1].y = bv; else xs[rp >> 1].x = bv;
        ov[r * 72] = (unsigned short)(pk2(bv * sv, 0.f) & 0xffffu); ow[r * 72] = (unsigned short)(pk2(bv * sw, 0.f) & 0xffffu);
#pragma unroll
        for (int q = 0; q < 16; ++q) cur[q] = nxt[q]; }
}

DI void prep_unit(const Args& a, int l, int pu, LAS unsigned char* lds) {
    const int tid = ltid(), lane = tid & 63, wave = tid >> 6;
    asm volatile("" : "+s"(pu));
    const int h = pu & 7, j = (pu >> 3) & 31, b = pu >> 8;
    constexpr int RAW_PITCH = 784;
    LAS unsigned char* RAW = lds;
    LAS float* LM = (LAS float*)lds;
    LAS unsigned short* AM = (LAS unsigned short*)(lds + 33856);
    LAS unsigned short* KB = (LAS unsigned short*)(lds + 53312);
    LAS unsigned short* QB = (LAS unsigned short*)(lds + 70720);
    LAS unsigned short* VT = (LAS unsigned short*)(lds + 88128);
    LAS unsigned short* KT = (LAS unsigned short*)(lds + 106560);
    LAS float* SM = (LAS float*)(lds + 124992);
    const bf16_t* pq = (const bf16_t*)(a.ws + WS_PQKV);
    for (int ci = tid; ci < 68 * 48; ci += NTHREADS) { const int rr = ci / 48, rem = ci % 48, tn = rem >> 4, c16 = rem & 15; const int tok = j * 64 - 2 + rr;
        u32x4 v = (u32x4){0u, 0u, 0u, 0u};
        if (tok >= 0 && tok < SEQ) v = *(const u32x4*)(pq + (size_t)(b * SEQ + tok) * 3072 + tn * 1024 + h * 128 + c16 * 8);
        *(LAS u32x4*)(RAW + rr * RAW_PITCH + tn * 256 + c16 * 16) = v; }
    LBAR();
    if (tid < 384) { const int tn = tid >> 7, rb = (tid & 127) >> 3, cs = tid & 7, r0 = rb * 4; const float* cw = a.in[3] + (size_t)l * 5 * 3072 + tn * 1024 + h * 128 + cs * 16;
        f32x4 w[5][4];
#pragma unroll
        for (int i = 0; i < 5; ++i) { const f32x4* wp = (const f32x4*)(cw + (size_t)i * 3072); w[i][0] = wp[0]; w[i][1] = wp[1]; w[i][2] = wp[2]; w[i][3] = wp[3]; }
        float acc[4][16];
#pragma unroll
        for (int jj = 0; jj < 4; ++jj)
#pragma unroll
            for (int c = 0; c < 16; ++c) acc[jj][c] = 0.f;
#pragma unroll
        for (int rr = 0; rr < 8; ++rr) { const LAS u32x4* xp = (const LAS u32x4*)(RAW + (r0 + rr) * RAW_PITCH + tn * 256 + cs * 32); float x[16]; { float x0[8], x1[8]; unpack8(xp[0], x0); unpack8(xp[1], x1);
#pragma unroll
              for (int c = 0; c < 8; ++c) { x[c] = x0[c]; x[8 + c] = x1[c]; } }
#pragma unroll
            for (int jj = 0; jj < 4; ++jj) { const int i = rr - jj; if (i >= 0 && i < 5) {
#pragma unroll
                for (int c = 0; c < 16; ++c) acc[jj][c] += x[c] * w[i][c >> 2][c & 3]; } } }
        float rs[4];
#pragma unroll
        for (int jj = 0; jj < 4; ++jj) { float ss = 0.f;
#pragma unroll
            for (int c = 0; c < 16; ++c) { acc[jj][c] = siluf_(acc[jj][c]); ss += acc[jj][c] * acc[jj][c]; }
            ss += __shfl_xor(ss, 1); ss += __shfl_xor(ss, 2); ss += __shfl_xor(ss, 4);
            rs[jj] = tn == 2 ? 1.f : rsqrtf(ss + RMS_EPS) * (tn == 0 ? 0.08838834764831845f : 1.0f);
#pragma unroll
            for (int c = 0; c < 16; ++c) acc[jj][c] *= rs[jj];
            if (tn < 2) { LAS unsigned short* dst = (tn == 0 ? QB : KB) + (r0 + jj) * 136 + cs * 16;
#pragma unroll
                for (int c = 0; c < 16; c += 2) *(LAS unsigned*)(dst + c) = pk2(acc[jj][c], acc[jj][c + 1]); } }
        if (tn >= 1) { LAS unsigned short* tp = (tn == 1 ? KT : VT) + (cs * 16) * 72 + r0;
#pragma unroll
            for (int c = 0; c < 16; ++c) { u32x2 wv; wv.x = pk2(acc[0][c], acc[1][c]); wv.y = pk2(acc[2][c], acc[3][c]); *(LAS u32x2*)(tp + c * 72) = wv; } } }
    if (wave == 7) {
        const int tok = b * SEQ + j * 64 + lane; const float* ba = (const float*)(a.ws + WS_BA) + (size_t)tok * 32;
        const float blf = ba[h], blb = ba[8 + h], alf = ba[16 + h], alb = ba[24 + h];
        const float af = expf(a.in[4][(l * 2 + 0) * NH + h]), ab = expf(a.in[4][(l * 2 + 1) * NH + h]);
        const float xf = alf + a.in[5][(l * 2 + 0) * NH + h], xb = alb + a.in[5][(l * 2 + 1) * NH + h];
        const float spf = xf > 20.f ? xf : log1pf(expf(xf)), spb = xb > 20.f ? xb : log1pf(expf(xb));
        const float gf = -af * spf, gb = -ab * spb;
        float pf = gf, pb = gb;
#pragma unroll
        for (int o = 1; o < 64; o <<= 1) { const float tf = __shfl_up(pf, o), tb = __shfl_up(pb, o); if (lane >= o) { pf += tf; pb += tb; } }
        const float totb = __shfl(pb, 63); const float gcb = totb - pb + gb;
        SM[lane] = sigmoidf_(blf); SM[64 + lane] = sigmoidf_(blb); SM[128 + lane] = pf; SM[192 + lane] = gcb; SM[256 + lane] = expf(pf); SM[320 + lane] = expf(gcb); }
    LBAR();
    bf16_t* rec[2] = {rec_ptr(a, b, h, 0, j), rec_ptr(a, b, h, 1, j)};
    { const int mat = wave >> 2, mb = wave & 1, nb = (wave >> 1) & 1, r = lane & 31, hh = lane >> 5; f32x16 acc;
#pragma unroll
      for (int i = 0; i < 16; ++i) acc[i] = 0.f;
      const LAS unsigned short* Ap = (mat ? QB : KB) + (32 * mb + r) * 136 + 8 * hh; const LAS unsigned short* Bp = KB + (32 * nb + r) * 136 + 8 * hh;
#pragma unroll
      for (int ks = 0; ks < 8; ++ks) { const bf16x8 af = *(const LAS bf16x8*)(Ap + 16 * ks), bfr = *(const LAS bf16x8*)(Bp + 16 * ks); acc = MFMA32(af, bfr, acc); }
      const int s = 32 * nb + r; const float gcf_s = SM[128 + s], gcb_s = SM[192 + s];
#pragma unroll
      for (int i = 0; i < 16; ++i) { const int c = 32 * mb + crow(i, hh); const float df = SM[128 + c] - gcf_s, db = SM[192 + c] - gcb_s;
          const float ef = __expf(fminf(df, 0.f)), eb = __expf(fminf(db, 0.f));
          if (mat == 0) { LM[c * 64 + s] = (c > s) ? SM[c] * acc[i] * ef : 0.f; LM[4096 + (63 - c) * 64 + (63 - s)] = (c < s) ? SM[64 + c] * acc[i] * eb : 0.f; }
          else { rec[0][REC_QK + c * 64 + s] = (bf16_t)(pk2((c >= s) ? acc[i] * ef : 0.f, 0.f) & 0xffffu); rec[1][REC_QK + c * 64 + s] = (bf16_t)(pk2((c <= s) ? acc[i] * eb : 0.f, 0.f) & 0xffffu); } } }
    LBAR();
    if (wave == 0) solve_T<0>(LM, SM, AM, AM + 4608, lane);
    else if (wave == 1) solve_T<1>(LM, SM, AM + 9216, AM + 13824, lane);
    else {
        for (int it = tid - 128; it < 512; it += 384) { const int r = it >> 3, cs = it & 7; const float ef = SM[256 + r], eb = SM[320 + r]; float o[8];
            const LAS u32x4* qp = (const LAS u32x4*)(QB + r * 136 + cs * 16); float q0[8], q1[8]; unpack8(qp[0], q0); unpack8(qp[1], q1);
#pragma unroll
            for (int d = 0; d < 2; ++d) { const float e = d ? eb : ef;
#pragma unroll
                for (int c = 0; c < 8; ++c) o[c] = q0[c] * e;
                *(u32x4*)(rec[d] + REC_QG + r * 128 + cs * 16) = pack8(o);
#pragma unroll
                for (int c = 0; c < 8; ++c) o[c] = q1[c] * e;
                *(u32x4*)(rec[d] + REC_QG + r * 128 + cs * 16 + 8) = pack8(o); } }
        const float glf = SM[128 + 63], glb = SM[192 + 0];
        for (int it = tid - 128; it < 512; it += 384) { const int dd = it >> 2, cq = it & 3; float k0[8], k1[8];
            const LAS u32x4* kp = (const LAS u32x4*)(KT + dd * 72 + cq * 16); unpack8(kp[0], k0); unpack8(kp[1], k1);
#pragma unroll
            for (int d = 0; d < 2; ++d) { float o[8];
#pragma unroll
                for (int i = 0; i < 8; ++i) { const int c = cq * 16 + i; o[i] = k0[i] * (d ? __expf(glb - SM[192 + c]) : __expf(glf - SM[128 + c])); }
                *(u32x4*)(rec[d] + REC_KDT + dd * 64 + cq * 16) = pack8(o);
#pragma unroll
                for (int i = 0; i < 8; ++i) { const int c = cq * 16 + 8 + i; o[i] = k1[i] * (d ? __expf(glb - SM[192 + c]) : __expf(glf - SM[128 + c])); }
                *(u32x4*)(rec[d] + REC_KDT + dd * 64 + cq * 16 + 8) = pack8(o); } }
        if (tid == 128) { float* eg = (float*)(a.ws + WS_EGP); eg[(size_t)(((b * NH + h) * 2 + 0) * 32 + j) * 32] = __expf(glf); eg[(size_t)(((b * NH + h) * 2 + 1) * 32 + j) * 32] = __expf(glb); }
    }
    LBAR();
    { const int p = wave >> 1, mb = wave & 1, r = lane & 31, hh = lane >> 5;
      const LAS unsigned short* Ap = AM + p * 4608 + (32 * mb + r) * 72 + 8 * hh; const LAS unsigned short* Bt = (p & 1) ? KT : VT;
      bf16x8 af[4];
#pragma unroll
      for (int ks = 0; ks < 4; ++ks) af[ks] = *(const LAS bf16x8*)(Ap + 16 * ks);
      bf16_t* outp = rec[p >> 1] + ((p & 1) ? REC_W : REC_U) + (32 * mb) * 128 + r;
#pragma unroll
      for (int nbk = 0; nbk < 4; ++nbk) { f32x16 acc;
#pragma unroll
          for (int i = 0; i < 16; ++i) acc[i] = 0.f;
          const LAS unsigned short* Bp = Bt + (32 * nbk + r) * 72 + 8 * hh;
#pragma unroll
          for (int ks = 0; ks < 4; ++ks) { const bf16x8 bfr = *(const LAS bf16x8*)(Bp + 16 * ks); acc = MFMA32(af[ks], bfr, acc); }
#pragma unroll
          for (int i = 0; i < 16; ++i) outp[crow(i, hh) * 128 + 32 * nbk] = (bf16_t)(pk2(acc[i], 0.f) & 0xffffu); } }
    LBAR();
}

DI void scan_unit(const Args& a, int su, LAS unsigned char* lds) {
    const int tid = ltid(), lane = tid & 63, wave = tid >> 6, r = lane & 31, hh = lane >> 5;
    const int vs = su & 1, dir = (su >> 1) & 1, h = (su >> 2) & 7, b = su >> 5;
    LAS unsigned char* Lw = lds;
    LAS unsigned char* Lqg = lds + 17408;
    LAS unsigned char* Lkd0 = lds + 34816;
    LAS unsigned char* Lqk0 = lds + 71680;
    LAS unsigned char* Lu = lds + 90112;
    LAS unsigned char* LS = lds + 99328;
    LAS unsigned char* LV = lds + 116736;
    const float* EG = (const float*)(a.ws + WS_EGP) + (size_t)(((b * NH + h) * 2 + dir) * 32) * 32;
    const float egv = EG[(lane & 31) * 32];
    float* O = (float*)(a.ws + WS_OF) + (size_t)dir * MTOK * 1024;
    for (int i = tid; i < 17408 / 4; i += NTHREADS) ((LAS unsigned*)LS)[i] = 0u;
    f32x16 Sacc;
#pragma unroll
    for (int i = 0; i < 16; ++i) Sacc[i] = 0.f;
    u32x4 preA[8], preB[8];
#define SCAN_PREFETCH(pre, jx) do { const unsigned char* rb = (const unsigned char*)rec_ptr(a, b, h, dir, (jx)); \
        _Pragma("unroll") for (int i = 0; i < 2; ++i) { const int ci = tid + 512 * i; pre[i] = *(const u32x4*)(rb + REC_W * 2 + (ci >> 4) * 256 + (ci & 15) * 16); pre[2 + i] = *(const u32x4*)(rb + REC_QG * 2 + (ci >> 4) * 256 + (ci & 15) * 16); \
            pre[4 + i] = *(const u32x4*)(rb + REC_KDT * 2 + (ci >> 3) * 128 + (ci & 7) * 16); } \
        pre[6] = *(const u32x4*)(rb + REC_QK * 2 + (tid >> 3) * 128 + (tid & 7) * 16); \
        pre[7] = *(const u32x4*)(rb + REC_U * 2 + (tid >> 3) * 256 + vs * 128 + (tid & 7) * 16); } while (0)
    SCAN_PREFETCH(preA, dir ? 31 : 0);
    SCAN_PREFETCH(preB, dir ? 30 : 1);
    const int mb = wave & 1, nb = (wave >> 1) & 1, kb = wave & 3, nb2 = wave >> 2;
#define SCAN_STEP(pre, step) do { const int j = dir ? 31 - (step) : (step); LAS unsigned char* Lkd = Lkd0 + ((step) & 1) * 18432; LAS unsigned char* Lqk = Lqk0 + ((step) & 1) * 9216; \
        _Pragma("unroll") for (int i = 0; i < 2; ++i) { const int ci = tid + 512 * i; *(LAS u32x4*)(Lw + (ci >> 4) * 272 + (ci & 15) * 16) = pre[i]; *(LAS u32x4*)(Lqg + (ci >> 4) * 272 + (ci & 15) * 16) = pre[2 + i]; \
            *(LAS u32x4*)(Lkd + (ci >> 3) * 144 + (ci & 7) * 16) = pre[4 + i]; } \
        *(LAS u32x4*)(Lqk + (tid >> 3) * 144 + (tid & 7) * 16) = pre[6]; \
        *(LAS u32x4*)(Lu + (tid >> 3) * 144 + (tid & 7) * 16) = pre[7]; \
        LBAR(); \
        if ((step) + 2 < 32) SCAN_PREFETCH(pre, dir ? 29 - (step) : (step) + 2); \
        const float eg = __shfl(egv, j); \
        f32x16 acc; \
        _Pragma("unroll") for (int i = 0; i < 16; ++i) acc[i] = 0.f; \
        { const LAS unsigned char* Ap = (wave < 4 ? Lw : Lqg) + (32 * mb + r) * 272 + 16 * hh; const LAS unsigned char* Bp = LS + (32 * nb + r) * 272 + 16 * hh; \
          _Pragma("unroll") for (int ks = 0; ks < 8; ++ks) { const bf16x8 af = *(const LAS bf16x8*)(Ap + 32 * ks), bfr = *(const LAS bf16x8*)(Bp + 32 * ks); acc = MFMA32(af, bfr, acc); } } \
        if (wave < 4) { \
            _Pragma("unroll") for (int g4 = 0; g4 < 4; ++g4) { float vn[4]; \
                _Pragma("unroll") for (int jj = 0; jj < 4; ++jj) { const int row = 32 * mb + 8 * g4 + 4 * hh + jj; vn[jj] = bf2f(*(const LAS unsigned short*)(Lu + row * 144 + (32 * nb + r) * 2)) - acc[4 * g4 + jj]; } \
                u32x2 w; w.x = pk2(vn[0], vn[1]); w.y = pk2(vn[2], vn[3]); \
                *(LAS u32x2*)(LV + (32 * nb + r) * 144 + (32 * mb + 8 * g4 + 4 * hh) * 2) = w; } } \
        LBAR(); \
        if (wave >= 4) { \
            const LAS unsigned char* Ap = Lqk + (32 * mb + r) * 144 + 16 * hh; const LAS unsigned char* Bp = LV + (32 * nb + r) * 144 + 16 * hh; \
            _Pragma("unroll") for (int ks = 0; ks < 4; ++ks) { const bf16x8 af = *(const LAS bf16x8*)(Ap + 32 * ks), bfr = *(const LAS bf16x8*)(Bp + 32 * ks); acc = MFMA32(af, bfr, acc); } \
            float* op = O + (size_t)(b * SEQ + j * 64 + 32 * mb) * 1024 + h * 128 + vs * 64 + 32 * nb + r; \
            _Pragma("unroll") for (int i = 0; i < 16; ++i) op[(size_t)crow(i, hh) * 1024] = acc[i]; \
        } \
        { \
            _Pragma("unroll") for (int i = 0; i < 16; ++i) Sacc[i] *= eg; \
            const LAS unsigned char* Ap = Lkd + (32 * kb + r) * 144 + 16 * hh; const LAS unsigned char* Bp = LV + (32 * nb2 + r) * 144 + 16 * hh; \
            _Pragma("unroll") for (int ks = 0; ks < 4; ++ks) { const bf16x8 af = *(const LAS bf16x8*)(Ap + 32 * ks), bfr = *(const LAS bf16x8*)(Bp + 32 * ks); Sacc = MFMA32(af, bfr, Sacc); } \
        } \
        _Pragma("unroll") for (int g4 = 0; g4 < 4; ++g4) { u32x2 w; w.x = pk2(Sacc[4 * g4], Sacc[4 * g4 + 1]); w.y = pk2(Sacc[4 * g4 + 2], Sacc[4 * g4 + 3]); \
            *(LAS u32x2*)(LS + (32 * nb2 + r) * 272 + (32 * kb + 8 * g4 + 4 * hh) * 2) = w; } \
    } while (0)
    for (int step = 0; step < 32; step += 2) { SCAN_STEP(preA, step); SCAN_STEP(preB, step + 1); }
#undef SCAN_STEP
#undef SCAN_PREFETCH
    __syncthreads();
}

DI void s5_carry(const Args& a, int l, int g) {
    const int tid = ltid(), bq = tid >> 7, dir = (tid >> 6) & 1, p = tid & 63;
    const int idx = ((l * 2 + dir) * NG + g) * NP + p;
    const float lr = a.in[7][idx], li = a.in[8][idx], dt = expf(a.in[9][(l * 2 + dir) * NG + g]);
    double rv = (double)li * (double)dt * 0.15915494309189535 * 32.0; rv -= rint(rv);
    const float e = expf(32.f * lr * dt), Tr = e * __builtin_amdgcn_cosf((float)rv), Ti = e * __builtin_amdgcn_sinf((float)rv);
    const float* E = (const float*)(a.ws + WS_EBUF) + (size_t)g * 256 * 256 + dir * 128 + p;
    bf16_t* A = (bf16_t*)(a.ws + WS_AS5) + (size_t)g * 256 * KY + 512 + dir * 128 + p;
    float cr = 0.f, ci = 0.f;
    for (int j0 = 0; j0 < 64; j0 += 16) { float er[16], ei[16];
#pragma unroll
        for (int k = 0; k < 16; ++k) { const int n = bq * 64 + (dir ? 63 - (j0 + k) : (j0 + k)); er[k] = E[(size_t)n * 256]; ei[k] = E[(size_t)n * 256 + 64]; }
#pragma unroll
        for (int k = 0; k < 16; ++k) { const int n = bq * 64 + (dir ? 63 - (j0 + k) : (j0 + k));
            A[(size_t)n * KY] = (bf16_t)(pk2(cr, 0.f) & 0xffffu); A[(size_t)n * KY + 64] = (bf16_t)(pk2(ci, 0.f) & 0xffffu);
            const float nr = Tr * cr - Ti * ci + er[k], ni = Tr * ci + Ti * cr + ei[k]; cr = nr; ci = ni; } }
    __syncthreads();
}

DI void post_a_rows2(const Args& a, int l, int tok0, int tok1, int lane) {
    const float* hg = a.in[6] + (size_t)l * HD + (lane & 7) * 16;
    f32x4 xf[2][4], xb[2][4]; u32x4 zz[2][2];
#pragma unroll
    for (int t = 0; t < 2; ++t) { const int tok = t ? tok1 : tok0;
        const float* of = (const float*)(a.ws + WS_OF) + (size_t)tok * 1024 + lane * 16; const float* ob = of + (size_t)MTOK * 1024;
        const u32x4* zp = (const u32x4*)((const bf16_t*)(a.ws + WS_ZA) + (size_t)tok * 1024 + lane * 16);
#pragma unroll
        for (int c = 0; c < 4; ++c) { xf[t][c] = ((const f32x4*)of)[c]; xb[t][c] = ((const f32x4*)ob)[c]; }
        zz[t][0] = zp[0]; zz[t][1] = zp[1]; }
#pragma unroll
    for (int t = 0; t < 2; ++t) { const int tok = t ? tok1 : tok0;
        float o[16]; float ss = 0.f;
#pragma unroll
        for (int c = 0; c < 4; ++c) { const f32x4 x = xf[t][c] + xb[t][c]; o[4 * c] = x.x; o[4 * c + 1] = x.y; o[4 * c + 2] = x.z; o[4 * c + 3] = x.w; ss += (x.x * x.x + x.y * x.y) + (x.z * x.z + x.w * x.w); }
        ss += __shfl_xor(ss, 1); ss += __shfl_xor(ss, 2); ss += __shfl_xor(ss, 4);
        const float rs = rsqrtf(ss * (1.f / HD) + RMS_EPS);
        float z0[8], z1[8]; unpack8(zz[t][0], z0); unpack8(zz[t][1], z1);
        float r0[8], r1[8];
#pragma unroll
        for (int c = 0; c < 8; ++c) { r0[c] = o[c] * rs * hg[c] * siluf_(z0[c]); r1[c] = o[8 + c] * rs * hg[8 + c] * siluf_(z1[c]); }
        u32x4* dp = (u32x4*)((bf16_t*)(a.ws + WS_AA) + (size_t)tok * 2048 + lane * 16); dp[0] = pack8(r0); dp[1] = pack8(r1); }
}

DI void final_row(const Args& a, int row, int lane) {
    const f32x4* xr = (const f32x4*)((const float*)(a.ws + WS_X) + (size_t)row * DM) + lane; f32x4 v[8]; float s = 0.f;
#pragma unroll
    for (int j = 0; j < 8; ++j) { v[j] = xr[64 * j]; s += (v[j].x * v[j].x + v[j].y * v[j].y) + (v[j].z * v[j].z + v[j].w * v[j].w); }
    const float rstd = rsqrtf(wave_sum(s) * (1.f / DM) + RMS_EPS);
    f32x4* o = (f32x4*)(a.out + (size_t)row * DM) + lane;
#pragma unroll
    for (int j = 0; j < 8; ++j) { const f32x4 gg = ((const f32x4*)a.in[21])[lane + 64 * j]; o[64 * j] = v[j] * rstd * gg; }
}


#define XB_TMO      128
#define XB_XCNT(j)  (256  + 64 * (j))
#define XB_XSUB(j)  (1280 + 64 * (j))
#define XB_XGEN(j)  (2304 + 64 * (j))
#define XB_TOP      3328
#define XB_TOPGEN   3392
#define XCD_BAR_WORDS 3456
#define XB_SPIN_CAP (1u << 22)
DI unsigned xb_ld(unsigned* p)              { return __hip_atomic_load(p, __ATOMIC_RELAXED, __HIP_MEMORY_SCOPE_AGENT); }
DI unsigned xb_add(unsigned* p, unsigned v) { return __hip_atomic_fetch_add(p, v, __ATOMIC_RELAXED, __HIP_MEMORY_SCOPE_AGENT); }
DI unsigned xb_xcc_id() { return (unsigned)__builtin_amdgcn_s_getreg((3 << 11) | 20) & 0xFu; }
#define XB_SPIN(cond, bar) do { unsigned _sp = 0; while (cond) { __builtin_amdgcn_s_sleep(1); \
    if ((++_sp & 255u) == 0u) { if (xb_ld(&(bar)[XB_TMO])) break; if (_sp > XB_SPIN_CAP) { atomicAdd(&(bar)[XB_TMO], 1u); break; } } } } while (0)
struct XcdBarrier { unsigned* bar; unsigned x; volatile LAS unsigned* st; };
DI XcdBarrier xcd_barrier_post(unsigned* bar, volatile LAS unsigned* st) {
    XcdBarrier b; b.bar = bar; b.x = xb_xcc_id(); b.st = st;
    if (__builtin_amdgcn_workitem_id_x() == 0) (void)xb_add(&bar[XB_XCNT(b.x)], 1u);
    return b;
}
DI void xcd_barrier_complete(unsigned* bar, unsigned x, unsigned& nloc, unsigned& nx) {
    const unsigned G = gridDim.x * gridDim.y * gridDim.z;
    unsigned sum, cnt, mine, sp = 0u;
    for (;;) {
        sum = 0u; cnt = 0u; mine = 0u;
#pragma unroll
        for (unsigned j = 0; j < 16; ++j) { const unsigned c = xb_ld(&bar[XB_XCNT(j)]); sum += c; cnt += (c > 0u) ? 1u : 0u; mine = (j == x) ? c : mine; }
        if (sum == G) break;
        __builtin_amdgcn_s_sleep(1);
        if ((++sp & 255u) == 0u) { if (xb_ld(&bar[XB_TMO])) break; if (sp > XB_SPIN_CAP) { atomicAdd(&bar[XB_TMO], 1u); break; } }
    }
    nloc = mine > 0u ? mine : 1u; nx = cnt > 0u ? cnt : 1u;
}
DI void xcd_barrier(const XcdBarrier& b) {
    asm volatile("s_waitcnt vmcnt(0)" ::: "memory");
    __syncthreads();
    if (__builtin_amdgcn_workitem_id_x() == 0) {
        unsigned* bar = b.bar;
        __builtin_amdgcn_s_waitcnt(0);
        unsigned nloc = b.st[0], nx = b.st[1];
        if (nloc == 0u) { xcd_barrier_complete(bar, b.x, nloc, nx); b.st[0] = nloc; b.st[1] = nx; }
        const unsigned old = xb_add(&bar[XB_XSUB(b.x)], 1u);
        const unsigned gen = old / nloc;
        if (old + 1u == (gen + 1u) * nloc) {
            __builtin_amdgcn_fence(__ATOMIC_RELEASE, "agent");
            asm volatile("s_waitcnt vmcnt(0)" ::: "memory");
            const unsigned og = xb_add(&bar[XB_TOP], 1u);
            const unsigned tg = og / nx;
            if (og + 1u == (tg + 1u) * nx) xb_add(&bar[XB_TOPGEN], 1u);
            else XB_SPIN(xb_ld(&bar[XB_TOPGEN]) == tg, bar);
            __builtin_amdgcn_fence(__ATOMIC_ACQUIRE, "agent");
            xb_add(&bar[XB_XGEN(b.x)], 1u);
            asm volatile("s_waitcnt vmcnt(0)" ::: "memory");
        } else {
            XB_SPIN(xb_ld(&bar[XB_XGEN(b.x)]) == gen, bar);
            __builtin_amdgcn_fence(__ATOMIC_ACQUIRE, "agent");
            asm volatile("s_waitcnt vmcnt(0)" ::: "memory");
        }
    }
    __syncthreads();
}

constexpr int NPHASE = 2 + 7 * DEPTH;
__global__ void __launch_bounds__(NTHREADS, 2) mega(Args a) {
    extern __shared__ __attribute__((aligned(16))) unsigned char lds_raw[];
    LAS unsigned char* lds = (LAS unsigned char*)lds_raw;
    const int G = gridDim.x, bid = blockIdx.x;
#if !MULTI_LAUNCH
    volatile LAS unsigned* bst = (volatile LAS unsigned*)(lds + LDS_BYTES - 64);
    if (__builtin_amdgcn_workitem_id_x() == 0) { bst[0] = 0u; bst[1] = 0u; }
    __syncthreads();
    (void)xcd_barrier_post((unsigned*)(a.ws + WS_CTL) + 1024, bst);
#endif
    for (int ph = a.lo; ph < a.hi; ++ph) {
        {
        const int tid = ltid(), lane = tid & 63, wave = tid >> 6;
        unsigned char* ws = a.ws; asm volatile("" : "+s"(ws));
        if (ph == 0) { if (PM & 1) phase_prologue(a, lds); }
        else if (ph == NPHASE - 1) { if (PM & 2) for (int row = bid * NWAVES + wave; row < MTOK; row += G * NWAVES) final_row(a, row, lane); }
        else {
            const int l = (ph - 1) / 7, k = (ph - 1) % 7;
            if (k == 0) { if (PM & 4) phase_norm(a, l, lds); }
            else if (k == 1) { if (PM & 8) {
                pg8::Gemm g{(const bf16_t*)(ws + WS_H), (const bf16_t*)(ws + WS_WIN + (size_t)l * SZ_WIN), DM, DM, DM}; pg8::StaticOrder S; S.init(MTOK, NMAIN, G, bid);
                EpiInProj E{(bf16_t*)(ws + WS_PQKV), (bf16_t*)(ws + WS_ZA), (bf16_t*)(ws + WS_AS5), (bf16_t*)(ws + WS_ZB), (bf16_t*)(ws + WS_GT), a.in[19] + (size_t)l * 4096};
                pg8::gemm_phase(lds, g, S, E);
            } } else if (k == 2) {
                if (PM & 32) {
                for (int pu = bid; pu < NB * 32 * NH; pu += G) prep_unit(a, l, pu, lds); }
            } else if (k == 3) {
                const int half = G / 2;
                if (bid < half) { if (PM & 64) for (int su = bid; su < 128; su += half) scan_unit(a, su, lds); }
                else { for (int yu = bid - half; yu < 128; yu += G - half) {
                        { pg8::Gemm g{(const bf16_t*)(ws + WS_AS5), (const bf16_t*)(ws + WS_BTE + (size_t)l * SZ_BTE), KY, KE, KE}; pg8::ListOrder S{yu >> 1, 1 << 30, NG, 0}; EpiE E{(float*)(ws + WS_EBUF)};
                          pg8::gemm_phase(lds, g, S, E); }
                        __syncthreads();
                        s5_carry(a, l, yu >> 1);
                        pg8::Gemm g{(const bf16_t*)(ws + WS_AS5), (const bf16_t*)(ws + WS_BTY + (size_t)l * SZ_BTY), KY, KY, KY}; pg8::ListOrder S{yu, 1 << 30, 128, 1}; EpiY E{(bf16_t*)(ws + WS_YS)};
                        pg8::gemm_phase(lds, g, S, E); __syncthreads(); } }
            } else if (k == 4) {
                if (PM & 256) { pg8::Gemm g{(const bf16_t*)(ws + WS_YS), (const bf16_t*)(ws + WS_WGLU + (size_t)l * SZ_WGLU), WB, WB, WB}; pg8::StaticOrder S; S.init(MTOK, WB, G, bid);
                  EpiGlu E{(const bf16_t*)(ws + WS_YS), (const bf16_t*)(ws + WS_ZB), a.in[16] + (size_t)l * WB, (bf16_t*)(ws + WS_AA)};
                  pg8::gemm_phase(lds, g, S, E); }
                if (PM & 512) {
                const int nglu = (MTOK / 256) * (WB / 256);
                if (G > nglu) { if (bid >= nglu) { const int st = (G - nglu) * NWAVES; for (int row = (bid - nglu) * NWAVES + wave; row < MTOK; row += 2 * st) post_a_rows2(a, l, row, (row + st < MTOK) ? row + st : row, lane); } }
                else { const int st = G * NWAVES; for (int row = bid * NWAVES + wave; row < MTOK; row += 2 * st) post_a_rows2(a, l, row, (row + st < MTOK) ? row + st : row, lane); } }
            } else if (k == 5) { if (PM & 1024) {
                pg8::StaticOrder S; S.init(MTOK, DM, G, bid);
                pg8::Gemm g{(const bf16_t*)(ws + WS_AA), (const bf16_t*)(ws + WS_WPA + (size_t)l * 2 * SZ_WPA), DM, DM, DM}; EpiMergeF E{(const bf16_t*)(ws + WS_GT), (bf16_t*)(ws + WS_MG)}; pg8::gemm_phase(lds, g, S, E);
            } } else { if (PM & 2048) {
                pg8::Gemm g{(const bf16_t*)(ws + WS_MG), (const bf16_t*)(ws + WS_WOUT + (size_t)l * SZ_WOUT), DM, DM, DM}; pg8::StaticOrder S; S.init(MTOK, DM, G, bid);
                EpiOut E{l == 0 ? a.in[0] : (const float*)(ws + WS_X), (float*)(ws + WS_X)};
                pg8::gemm_phase(lds, g, S, E);
            } }
        }
        __syncthreads(); }
#if !MULTI_LAUNCH
        if (ph + 1 < a.hi) { if (ph == a.lo) cg::this_grid().sync(); else { unsigned char* wsb = a.ws; asm volatile("" : "+s"(wsb)); XcdBarrier xb; xb.bar = (unsigned*)(wsb + WS_CTL) + 1024; xb.x = xb_xcc_id(); xb.st = (volatile LAS unsigned*)(lds + LDS_BYTES - 64); xcd_barrier(xb); } }
#endif
    }
}


extern "C" void kernel_launch(void* const* d_in, const int* in_sizes, int n_in, void* d_out, int out_size, void* d_ws, size_t ws_size, hipStream_t stream) {
    static int grid = 0;
    if (grid == 0) {
        int dev = 0, cus = 0, per_cu = 0;
        hipGetDevice(&dev); hipDeviceGetAttribute(&cus, hipDeviceAttributeMultiprocessorCount, dev);
        hipFuncSetAttribute((const void*)mega, hipFuncAttributeMaxDynamicSharedMemorySize, LDS_BYTES);
        hipOccupancyMaxActiveBlocksPerMultiprocessor(&per_cu, (const void*)mega, NTHREADS, LDS_BYTES);
        if (per_cu < 1) { fprintf(stderr, "kernel_launch: occupancy query says %d blocks/CU\n", per_cu); per_cu = 1; }
        grid = cus;
        if (ws_size < WS_END) fprintf(stderr, "kernel_launch: workspace too small: %zu < %zu\n", ws_size, (size_t)WS_END);
        (void)hipGetLastError();
    }
    hipMemsetAsync((char*)d_ws + WS_CTL, 0, 32768, stream);
    Args a{};
    for (int i = 0; i < 22; ++i) a.in[i] = (const float*)d_in[i];
    a.out = (float*)d_out; a.ws = (unsigned char*)d_ws;
#if MULTI_LAUNCH
    for (int ph = 0; ph < NPHASE; ++ph) { a.lo = ph; a.hi = ph + 1; hipLaunchKernelGGL(mega, dim3(grid), dim3(NTHREADS), LDS_BYTES, stream, a); }

#else
    a.lo = 0; a.hi = NPHASE;
    void* args[] = {&a};
    hipError_t e = hipLaunchCooperativeKernel((const void*)mega, dim3(grid), dim3(NTHREADS), args, LDS_BYTES, stream);
    if (e != hipSuccess) fprintf(stderr, "cooperative launch failed: %s (grid %d)\n", hipGetErrorString(e), grid);
#endif
}
```

```cpp
#include <hip/hip_runtime.h>
#include <hip/hip_cooperative_groups.h>
#include <cstdio>
namespace cg = cooperative_groups;


#ifndef PM
#define PM 0xFFFF
#endif
#ifndef MULTI_LAUNCH
#define MULTI_LAUNCH 0
#endif

#define DI __device__ __forceinline__
#define LAS __attribute__((address_space(3)))
typedef unsigned short bf16_t;
typedef short bf16x8 __attribute__((ext_vector_type(8)));
typedef float f32x4 __attribute__((ext_vector_type(4)));
typedef float f32x16 __attribute__((ext_vector_type(16)));
typedef unsigned u32x4 __attribute__((ext_vector_type(4)));
typedef unsigned u32x2 __attribute__((ext_vector_type(2)));

__device__ __forceinline__ int ltid() { int t = __builtin_amdgcn_workitem_id_x(); asm volatile("" : "+v"(t)); return t; }
namespace pg8 {
#define PG8_LAS __attribute__((address_space(3)))
constexpr int BM = 256, BK = 64, HALF = 128, HTB = HALF * BK * 2  , STAGE_BYTES = 8 * HTB, NXCD = 8, WGM = 4;

__host__ __device__ __forceinline__ int lds_byte(int r, int c) { const int st = (r >> 4) * 2 + (c >> 5), rr = r & 15, cc = c & 31, ob = rr * 64 + cc * 2; return st * 1024 + (ob ^ (((ob >> 9) & 1) << 5)); }
__host__ __device__ __forceinline__ void stage_rc(int b, int& R, int& C) { const int st = b / 1024, sb = b % 1024, swz = sb ^ (((sb >> 9) & 1) << 5); R = (st >> 1) * 16 + swz / 64; C = (st & 1) * 32 + (swz % 64) / 2; }
__host__ __device__ __forceinline__ int perm32(int rho) { const int n = rho >> 4, i = rho & 15; return 8 * (i >> 2) + 4 * n + (i & 3); }

struct Unit { int pm, pn; };
struct Gemm { const bf16_t* A; const bf16_t* Bt; int lda, ldb, K; };

struct StaticOrder {
    int nM, nN, nwg, G, c;
    __host__ __device__ void init(int M, int N, int G_, int c_) { nM = M / BM; nN = N / BM; nwg = nM * nN; G = G_; c = c_; }
    __host__ __device__ bool next(int i, Unit& u) const {
        const long L = (long)i * G + c; if (L >= nwg) return false;
        int wgid = (int)L; { const int q = nwg / NXCD, r = nwg % NXCD, xcd = wgid % NXCD, off = wgid / NXCD; wgid = (xcd < r ? xcd * (q + 1) : r * (q + 1) + (xcd - r) * q) + off; }
        const int nig = WGM * nN, gid = wgid / nig, fm = gid * WGM, gsz = (nM - fm) < WGM ? (nM - fm) : WGM;
        u.pm = fm + ((wgid % nig) % gsz); u.pn = (wgid % nig) / gsz; return true;
    }
    __device__ __forceinline__ void a_ready(const Unit&) const {}
    __device__ __forceinline__ void done(const Unit&) const {}
};
struct ListOrder {
    int first, stride, count, mode;
    __device__ __forceinline__ bool next(int i, Unit& u) const { const int idx = first + i * stride; if (idx >= count) return false; if (mode == 0) { u.pm = idx; u.pn = idx; } else { u.pm = idx >> 1; u.pn = idx; } return true; }
    __device__ __forceinline__ void a_ready(const Unit&) const {}
    __device__ __forceinline__ void done(const Unit&) const {}
};
typedef __bf16 bf16x2_t __attribute__((ext_vector_type(2)));
typedef float f32x2_t __attribute__((ext_vector_type(2)));
__device__ __forceinline__ unsigned cvt_pk_bf16(float lo, float hi) { f32x2_t v = {lo, hi}; bf16x2_t b = __builtin_convertvector(v, bf16x2_t); return __builtin_bit_cast(unsigned, b); }

template <class Epi, class Sched>
__device__ __forceinline__ void gemm_phase(PG8_LAS unsigned char* lds, const Gemm g, const Sched& S, const Epi& E) {
    const int tid = ltid(), wid = __builtin_amdgcn_readfirstlane(tid >> 6), lane = tid & 63, wr = wid >> 2, wc = wid & 3, fr = lane & 15, fq = lane >> 4;
    const int K = g.K, nt = K / BK;
    unsigned voffA[2], voffB[2];
#pragma unroll
    for (int i = 0; i < 2; ++i) { int R, C; stage_rc(tid * 16 + i * 8192, R, C); const int Rb = Epi::PERM ? ((R & ~31) + perm32(R & 31)) : R;
        voffA[i] = (unsigned)(R * g.lda + C) * 2u; voffB[i] = (unsigned)(Rb * g.ldb + C) * 2u; }
    const size_t kstep = (size_t)(BK * 2);
    const size_t hstepA = (size_t)HALF * g.lda * 2, hstepB = (size_t)HALF * g.ldb * 2;
    const size_t tstepA = 2 * hstepA, tstepB = 2 * hstepB;
    const unsigned ldsw = (unsigned)wid * 1024u;
    const int aoff = lds_byte(wr * 64 + fr, fq * 8), boff = lds_byte(wc * 32 + fr, fq * 8);
#define PG8_SA(b, h) (((b) * 2 + (h)) * HTB)
#define PG8_SB(b, h) ((4 + (b) * 2 + (h)) * HTB)
#define PG8_STAGE(bufoff, gbase, voff) do { _Pragma("unroll") for (int _i = 0; _i < 2; ++_i) \
        __builtin_amdgcn_global_load_lds((const unsigned*)((const char*)(gbase) + (voff)[_i]), (PG8_LAS unsigned*)(lds + (bufoff) + ldsw + _i * 8192), 16, 0, 0); } while (0)
#define PG8_LDA(dst, b, h) do { _Pragma("unroll") for (int m = 0; m < 4; ++m) _Pragma("unroll") for (int k = 0; k < 2; ++k) dst[m][k] = *(const PG8_LAS bf16x8*)(lds + PG8_SA(b, h) + aoff + m * 2048 + k * 1024); } while (0)
#define PG8_LDB(dst, b, h) do { _Pragma("unroll") for (int n = 0; n < 2; ++n) _Pragma("unroll") for (int k = 0; k < 2; ++k) dst[n][k] = *(const PG8_LAS bf16x8*)(lds + PG8_SB(b, h) + boff + n * 2048 + k * 1024); } while (0)
#define PG8_MMA(ai, bj, At, Bt) do { __builtin_amdgcn_s_setprio(1); _Pragma("unroll") for (int m = 0; m < 4; ++m) _Pragma("unroll") for (int n = 0; n < 2; ++n) _Pragma("unroll") for (int k = 0; k < 2; ++k) \
        acc[ai][bj][m][n] = __builtin_amdgcn_mfma_f32_16x16x32_bf16(Bt[n][k], At[m][k], acc[ai][bj][m][n], 0, 0, 0); __builtin_amdgcn_s_setprio(0); } while (0)
#define PG8_WAIT_V(n) asm volatile("s_waitcnt vmcnt(" #n ")" ::: "memory")
#define PG8_WAIT_L(n) asm volatile("s_waitcnt lgkmcnt(" #n ")" ::: "memory")
#define PG8_BAR __builtin_amdgcn_s_barrier()
#define PG8_SCHED __builtin_amdgcn_sched_barrier(0)
    Unit cur, nxt; int ui = 0;
    if (!S.next(0, cur)) return;
    f32x4 acc[2][2][4][2];
#pragma unroll
    for (int a = 0; a < 2; ++a)
#pragma unroll
        for (int b = 0; b < 2; ++b)
#pragma unroll
            for (int m = 0; m < 4; ++m)
#pragma unroll
                for (int n = 0; n < 2; ++n) acc[a][b][m][n] = (f32x4){0.f, 0.f, 0.f, 0.f};
    bf16x8 At[4][2], B0[2][2], B1[2][2];
    const char* cA = (const char*)g.A + (size_t)cur.pm * tstepA; const char* cB = (const char*)g.Bt + (size_t)cur.pn * tstepB;
    S.a_ready(cur);
    PG8_STAGE(PG8_SB(0, 0), cB, voffB); PG8_STAGE(PG8_SB(0, 1), cB + hstepB, voffB); PG8_STAGE(PG8_SA(0, 0), cA, voffA); PG8_STAGE(PG8_SA(0, 1), cA + hstepA, voffA);
    if (wr == 1) PG8_BAR;
    PG8_WAIT_V(2); PG8_BAR;
    PG8_STAGE(PG8_SB(1, 0), cB + kstep, voffB); PG8_STAGE(PG8_SA(1, 0), cA + kstep, voffA); PG8_STAGE(PG8_SB(1, 1), cB + hstepB + kstep, voffB);
    PG8_WAIT_V(6); PG8_BAR;
    for (;;) {
        const bool has_next = S.next(ui + 1, nxt);
        const char* nA = has_next ? (const char*)g.A + (size_t)nxt.pm * tstepA : cA; const char* nB = has_next ? (const char*)g.Bt + (size_t)nxt.pn * tstepB : cB;
        for (int khalf = 0; khalf < (Epi::HAS_MID ? 2 : 1); ++khalf) {
        const int kt0 = (Epi::HAS_MID && khalf) ? nt / 2 : 0, kt1 = (Epi::HAS_MID && !khalf) ? nt / 2 : nt;
        if constexpr (Epi::HAS_MID) { if (khalf) E.mid(acc, cur, wr, wc, fr, fq); }
        for (int t = kt0; t < kt1; t += 2) {
            const bool last = (t == nt - 2);
            const char* a1 = cA + (size_t)(t + 1) * kstep;
            const char* a2 = last ? nA : cA + (size_t)(t + 2) * kstep; const char* b2 = last ? nB : cB + (size_t)(t + 2) * kstep;
            const char* a3 = a2 + kstep; const char* b3 = b2 + kstep;
            if (last && has_next) S.a_ready(nxt);
            PG8_LDB(B0, 0, 0); PG8_LDB(B1, 0, 1); PG8_SCHED; PG8_LDA(At, 0, 0); PG8_STAGE(PG8_SA(1, 1), a1 + hstepA, voffA);
            PG8_WAIT_V(8); PG8_WAIT_L(0); PG8_BAR; PG8_MMA(0, 0, At, B0); PG8_MMA(0, 1, At, B1); PG8_BAR; PG8_SCHED;
            PG8_LDA(At, 0, 1); PG8_STAGE(PG8_SB(0, 0), b2, voffB); PG8_STAGE(PG8_SB(0, 1), b2 + hstepB, voffB); PG8_STAGE(PG8_SA(0, 0), a2, voffA);
            PG8_WAIT_V(8); PG8_WAIT_L(0); PG8_BAR; PG8_MMA(1, 0, At, B0); PG8_MMA(1, 1, At, B1); PG8_BAR; PG8_SCHED;
            PG8_LDB(B0, 1, 0); PG8_LDB(B1, 1, 1); PG8_SCHED; PG8_LDA(At, 1, 0); PG8_STAGE(PG8_SA(0, 1), a2 + hstepA, voffA);
            PG8_WAIT_V(8); PG8_WAIT_L(0); PG8_BAR; PG8_MMA(0, 0, At, B0); PG8_MMA(0, 1, At, B1); PG8_BAR; PG8_SCHED;
            PG8_LDA(At, 1, 1); PG8_STAGE(PG8_SB(1, 0), b3, voffB); PG8_STAGE(PG8_SB(1, 1), b3 + hstepB, voffB); PG8_STAGE(PG8_SA(1, 0), a3, voffA);
            PG8_WAIT_V(8); PG8_WAIT_L(0); PG8_BAR; PG8_MMA(1, 0, At, B0); PG8_MMA(1, 1, At, B1); PG8_BAR; PG8_SCHED;
        }
        }
        if (wr == 0) PG8_BAR;
        E(acc, cur, wr, wc, fr, fq); S.done(cur);
        if (!has_next) break;
#pragma unroll
        for (int a = 0; a < 2; ++a)
#pragma unroll
            for (int b = 0; b < 2; ++b)
#pragma unroll
                for (int m = 0; m < 4; ++m)
#pragma unroll
                    for (int n = 0; n < 2; ++n) acc[a][b][m][n] = (f32x4){0.f, 0.f, 0.f, 0.f};
        cur = nxt; cA = nA; cB = nB; ++ui;
        if (wr == 1) PG8_BAR;
    }
    PG8_WAIT_V(0);
    PG8_BAR;
#undef PG8_SA
#undef PG8_SB
#undef PG8_STAGE
#undef PG8_LDA
#undef PG8_LDB
#undef PG8_MMA
#undef PG8_WAIT_V
#undef PG8_WAIT_L
#undef PG8_BAR
#undef PG8_SCHED
}
}

constexpr int DM = 2048, NB = 4, SEQ = 2048, MTOK = NB * SEQ, DEPTH = 4;
constexpr int NH = 8, HD = 128, WA = 1024, WB = 1024, NG = 64, NP = 64, PROJ = 10272, NMAIN = 10240;
constexpr int TS5 = 32;
constexpr int KY = 768, KE = 512;
constexpr float RMS_EPS = 1e-6f;
constexpr int NTHREADS = 512, NWAVES = 8;
constexpr int LDS_BYTES = 147456;

constexpr size_t MiB = 1u << 20;
constexpr size_t alignup(size_t x) { return (x + 255) & ~(size_t)255; }
constexpr size_t WS_CTL = 0;
constexpr size_t SZ_WIN = (size_t)NMAIN * DM * 2, SZ_WBA = (size_t)32 * DM * 2, SZ_WGLU = (size_t)WB * WB * 2, SZ_WPA = (size_t)DM * WA * 2, SZ_WPB = (size_t)DM * WB * 2, SZ_WOUT = (size_t)DM * DM * 2;
constexpr size_t SZ_BTE = (size_t)NG * 256 * KE * 2, SZ_BTY = (size_t)NG * 512 * KY * 2;
constexpr size_t WS_EGP = 65536;
constexpr size_t WS_WIN = 1 * MiB;
constexpr size_t WS_WBA = WS_WIN + DEPTH * SZ_WIN;
constexpr size_t WS_WGLU = WS_WBA + DEPTH * SZ_WBA;
constexpr size_t WS_WPA = WS_WGLU + DEPTH * SZ_WGLU;
constexpr size_t WS_WPB = WS_WPA + DEPTH * SZ_WPA;
constexpr size_t WS_WOUT = WS_WPB + DEPTH * SZ_WPB;
constexpr size_t WS_BTE = WS_WOUT + DEPTH * SZ_WOUT;
constexpr size_t WS_BTY = WS_BTE + DEPTH * SZ_BTE;
constexpr size_t WS_X = WS_BTY + DEPTH * SZ_BTY;
constexpr size_t WS_H = WS_X + (size_t)MTOK * DM * 4;
constexpr size_t WS_BA = WS_H + (size_t)MTOK * DM * 2;
constexpr size_t WS_PQKV = WS_BA + (size_t)MTOK * 32 * 4;
constexpr size_t WS_ZA = WS_PQKV + (size_t)MTOK * 3072 * 2;
constexpr size_t WS_AS5 = WS_ZA + (size_t)MTOK * 1024 * 2;
constexpr size_t WS_ZB = WS_AS5 + (size_t)NG * 256 * KY * 2;
constexpr size_t WS_GT = WS_ZB + (size_t)MTOK * 1024 * 2;
constexpr size_t WS_EBUF = WS_GT + (size_t)MTOK * 4096 * 2;
constexpr size_t WS_YS = WS_EBUF + (size_t)NG * 256 * 256 * 4;
constexpr size_t WS_EG = WS_YS + (size_t)MTOK * 1024 * 2;
constexpr size_t WS_OF = WS_EG + 65536;
constexpr size_t WS_AA = WS_OF + (size_t)2 * MTOK * 1024 * 4;
constexpr size_t WS_AB = WS_AA + (size_t)MTOK * 1024 * 2;
constexpr size_t REC_BYTES = 73728;
constexpr size_t WS_REC = WS_AB + (size_t)MTOK * 1024 * 2;
constexpr size_t WS_TMP = WS_REC;
constexpr size_t WS_MG = WS_REC + (size_t)MTOK * DM * 4;
constexpr size_t WS_END = WS_REC + (size_t)4096 * REC_BYTES;
static_assert((size_t)MTOK * DM * 6 <= (size_t)4096 * REC_BYTES, "overlay");

struct Args { const float* in[22]; float* out; unsigned char* ws; int lo, hi, flags, pad; };

DI float bf2f(unsigned short b) { return __uint_as_float(((unsigned)b) << 16); }
DI unsigned pk2(float lo, float hi) { return pg8::cvt_pk_bf16(lo, hi); }
DI float sigmoidf_(float x) { return __builtin_amdgcn_rcpf(1.0f + __expf(-x)); }
DI float siluf_(float x) { return x * __builtin_amdgcn_rcpf(1.0f + __expf(-x)); }
DI float geluf_(float x) { return x * __builtin_amdgcn_rcpf(1.0f + __expf(-1.5957691216057308f * (x + 0.044715f * x * x * x))); }
DI void unpack8(const u32x4 v, float (&f)[8]) {
    f[0] = __uint_as_float(v.x << 16); f[1] = __uint_as_float(v.x & 0xffff0000u); f[2] = __uint_as_float(v.y << 16); f[3] = __uint_as_float(v.y & 0xffff0000u);
    f[4] = __uint_as_float(v.z << 16); f[5] = __uint_as_float(v.z & 0xffff0000u); f[6] = __uint_as_float(v.w << 16); f[7] = __uint_as_float(v.w & 0xffff0000u); }
DI u32x4 pack8(const float (&f)[8]) { u32x4 w; w.x = pk2(f[0], f[1]); w.y = pk2(f[2], f[3]); w.z = pk2(f[4], f[5]); w.w = pk2(f[6], f[7]); return w; }
DI float wave_sum(float v) {
#pragma unroll
    for (int o = 1; o < 64; o <<= 1) v += __shfl_xor(v, o);
    return v; }
#define MFMA32(a, b, c) __builtin_amdgcn_mfma_f32_32x32x16_bf16((a), (b), (c), 0, 0, 0)
DI int crow(int reg, int h) { return (reg & 3) + 8 * (reg >> 2) + 4 * h; }
#define LDS_WAIT() asm volatile("s_waitcnt lgkmcnt(0)" ::: "memory")
#define LBAR() do { asm volatile("s_waitcnt lgkmcnt(0)" ::: "memory"); __builtin_amdgcn_s_barrier(); asm volatile("" ::: "memory"); } while (0)

using pg8::Unit;
struct EpiInProj {
    static constexpr bool PERM = true, HAS_MID = false;
    bf16_t *pqkv, *za, *as5, *zb, *gt; const float* bgate;
    DI void operator()(const f32x4 (&acc)[2][2][4][2], const Unit& u, int wr, int wc, int fr, int fq) const {
        const int row0 = u.pm * 256 + wr * 64 + fr, colt = u.pn * 256;
#pragma unroll
        for (int ai = 0; ai < 2; ++ai)
#pragma unroll
            for (int m = 0; m < 4; ++m) { const int row = row0 + ai * 128 + m * 16;
#pragma unroll
                for (int bj = 0; bj < 2; ++bj) { const int col = colt + bj * 128 + wc * 32 + 8 * fq;
                    f32x4 v0 = acc[ai][bj][m][0], v1 = acc[ai][bj][m][1]; bf16_t* dst;
                    if (colt < 3072) dst = pqkv + (size_t)row * 3072 + col;
                    else if (colt < 4096) dst = za + (size_t)row * 1024 + (col - 3072);
                    else if (colt < 5120) { const int ch = col - 4096, g = ch >> 4, cp = ch & 15, n = row >> 5, s = row & 31; dst = as5 + ((size_t)(g * 256 + n) * KY + s * 16 + cp); }
                    else if (colt < 6144) dst = zb + (size_t)row * 1024 + (col - 5120);
                    else { const int gc = col - 6144; const f32x4 b0 = *(const f32x4*)(bgate + gc), b1 = *(const f32x4*)(bgate + gc + 4);
#pragma unroll
                        for (int j = 0; j < 4; ++j) { v0[j] = sigmoidf_(v0[j] + b0[j]); v1[j] = sigmoidf_(v1[j] + b1[j]); }
                        dst = gt + (size_t)row * 4096 + gc; }
                    u32x4 w; w.x = pk2(v0[0], v0[1]); w.y = pk2(v0[2], v0[3]); w.z = pk2(v1[0], v1[1]); w.w = pk2(v1[2], v1[3]);
                    *(u32x4*)dst = w; } }
    }
};
struct EpiE {
    static constexpr bool PERM = false, HAS_MID = false;
    float* E;
    DI void operator()(const f32x4 (&acc)[2][2][4][2], const Unit& u, int wr, int wc, int fr, int fq) const {
        float* base = E + (size_t)u.pm * 256 * 256;
#pragma unroll
        for (int ai = 0; ai < 2; ++ai)
#pragma unroll
            for (int m = 0; m < 4; ++m) { float* rowp = base + (size_t)(ai * 128 + wr * 64 + m * 16 + fr) * 256 + wc * 32 + 4 * fq;
#pragma unroll
                for (int bj = 0; bj < 2; ++bj)
#pragma unroll
                    for (int n = 0; n < 2; ++n) *(f32x4*)(rowp + bj * 128 + n * 16) = acc[ai][bj][m][n]; }
    }
};
struct EpiY {
    static constexpr bool PERM = true, HAS_MID = false;
    bf16_t* ys;
    DI void operator()(const f32x4 (&acc)[2][2][4][2], const Unit& u, int wr, int wc, int fr, int fq) const {
        const int g = u.pm, nt = u.pn & 1;
#pragma unroll
        for (int ai = 0; ai < 2; ++ai)
#pragma unroll
            for (int m = 0; m < 4; ++m) { const int n = ai * 128 + wr * 64 + m * 16 + fr;
#pragma unroll
                for (int bj = 0; bj < 2; ++bj) { const int cc = nt * 256 + bj * 128 + wc * 32 + 8 * fq, t = cc >> 4, c = cc & 15;
                    const f32x4 v0 = acc[ai][bj][m][0], v1 = acc[ai][bj][m][1];
                    float f[8] = {geluf_(v0[0]), geluf_(v0[1]), geluf_(v0[2]), geluf_(v0[3]), geluf_(v1[0]), geluf_(v1[1]), geluf_(v1[2]), geluf_(v1[3])};
                    *(u32x4*)(ys + ((size_t)(n * TS5 + t) * 1024 + g * 16 + c)) = pack8(f); } }
    }
};
struct EpiGlu {
    static constexpr bool PERM = true, HAS_MID = false;
    const bf16_t *ys, *zb; const float* bglu; bf16_t* ab;
    DI void operator()(const f32x4 (&acc)[2][2][4][2], const Unit& u, int wr, int wc, int fr, int fq) const {
        const int row0 = u.pm * 256 + wr * 64 + fr, colb = u.pn * 256 + wc * 32 + 8 * fq;
        f32x4 bb[2][2];
#pragma unroll
        for (int bj = 0; bj < 2; ++bj) { bb[bj][0] = *(const f32x4*)(bglu + colb + bj * 128); bb[bj][1] = *(const f32x4*)(bglu + colb + bj * 128 + 4); }
#pragma unroll
        for (int ai = 0; ai < 2; ++ai)
#pragma unroll
          for (int mp = 0; mp < 2; ++mp) { u32x4 yv[2][2], zv[2][2];
#pragma unroll
            for (int mm = 0; mm < 2; ++mm)
#pragma unroll
                for (int bj = 0; bj < 2; ++bj) { const size_t off = (size_t)(row0 + ai * 128 + (mp * 2 + mm) * 16) * 1024 + colb + bj * 128; yv[mm][bj] = *(const u32x4*)(ys + off); zv[mm][bj] = *(const u32x4*)(zb + off); }
#pragma unroll
            for (int mm = 0; mm < 2; ++mm)
#pragma unroll
                for (int bj = 0; bj < 2; ++bj) { const int m = mp * 2 + mm; const size_t off = (size_t)(row0 + ai * 128 + m * 16) * 1024 + colb + bj * 128;
                    const f32x4 v0 = acc[ai][bj][m][0], v1 = acc[ai][bj][m][1]; float y[8], z[8], o[8]; unpack8(yv[mm][bj], y); unpack8(zv[mm][bj], z);
#pragma unroll
                    for (int j = 0; j < 4; ++j) { o[j] = y[j] * sigmoidf_(v0[j] + bb[bj][0][j]) * siluf_(z[j]); o[4 + j] = y[4 + j] * sigmoidf_(v1[j] + bb[bj][1][j]) * siluf_(z[4 + j]); }
                    *(u32x4*)(ab + (size_t)(row0 + ai * 128 + m * 16) * 2048 + 1024 + colb + bj * 128) = pack8(o); } }
    }
};
struct EpiMergeF {
    static constexpr bool PERM = true, HAS_MID = true;
    const bf16_t* gt; bf16_t* mg;
    DI void mid(f32x4 (&acc)[2][2][4][2], const Unit& u, int wr, int wc, int fr, int fq) const {
        int row0 = u.pm * 256 + wr * 64 + fr, colb = u.pn * 256 + wc * 32 + 8 * fq; asm volatile("" : "+v"(row0), "+v"(colb));
#pragma unroll
        for (int ai = 0; ai < 2; ++ai)
#pragma unroll
            for (int mp = 0; mp < 2; ++mp) { u32x4 ga[2][2], gb[2][2];
#pragma unroll
                for (int mm = 0; mm < 2; ++mm)
#pragma unroll
                    for (int bj = 0; bj < 2; ++bj) { const bf16_t* gp = gt + (size_t)(row0 + ai * 128 + (mp * 2 + mm) * 16) * 4096 + colb + bj * 128; ga[mm][bj] = *(const u32x4*)gp; gb[mm][bj] = *(const u32x4*)(gp + 2048); }
#pragma unroll
                for (int mm = 0; mm < 2; ++mm)
#pragma unroll
                    for (int bj = 0; bj < 2; ++bj) { const int m = mp * 2 + mm; float a8[8], b8[8]; unpack8(ga[mm][bj], a8); unpack8(gb[mm][bj], b8);
#pragma unroll
                        for (int j = 0; j < 4; ++j) { acc[ai][bj][m][0][j] *= a8[j] * __builtin_amdgcn_rcpf(fmaxf(b8[j], 1e-30f)); acc[ai][bj][m][1][j] *= a8[4 + j] * __builtin_amdgcn_rcpf(fmaxf(b8[4 + j], 1e-30f)); } }
                asm volatile("" ::: "memory"); }
    }
    DI void operator()(const f32x4 (&acc)[2][2][4][2], const Unit& u, int wr, int wc, int fr, int fq) const {
        int row0 = u.pm * 256 + wr * 64 + fr, colb = u.pn * 256 + wc * 32 + 8 * fq; asm volatile("" : "+v"(row0), "+v"(colb));
#pragma unroll
        for (int ai = 0; ai < 2; ++ai) { u32x4 gb[4][2];
#pragma unroll
            for (int m = 0; m < 4; ++m)
#pragma unroll
                for (int bj = 0; bj < 2; ++bj) gb[m][bj] = *(const u32x4*)(gt + (size_t)(row0 + ai * 128 + m * 16) * 4096 + 2048 + colb + bj * 128);
#pragma unroll
            for (int m = 0; m < 4; ++m)
#pragma unroll
                for (int bj = 0; bj < 2; ++bj) { float b8[8], o[8]; unpack8(gb[m][bj], b8); const f32x4 v0 = acc[ai][bj][m][0], v1 = acc[ai][bj][m][1];
#pragma unroll
                    for (int j = 0; j < 4; ++j) { o[j] = b8[j] * v0[j]; o[4 + j] = b8[4 + j] * v1[j]; }
                    *(u32x4*)(mg + (size_t)(row0 + ai * 128 + m * 16) * 2048 + colb + bj * 128) = pack8(o); } }
    }
};
struct EpiOut {
    static constexpr bool PERM = false, HAS_MID = false;
    const float* xi; float* xo;
    DI void operator()(const f32x4 (&acc)[2][2][4][2], const Unit& u, int wr, int wc, int fr, int fq) const {
        const int row0 = u.pm * 256 + wr * 64 + fr, col0 = u.pn * 256 + wc * 32 + 4 * fq;
#pragma unroll
        for (int ai = 0; ai < 2; ++ai)
#pragma unroll
            for (int mp = 0; mp < 2; ++mp) { f32x4 rv[2][2][2];
#pragma unroll
                for (int mm = 0; mm < 2; ++mm)
#pragma unroll
                    for (int bj = 0; bj < 2; ++bj)
#pragma unroll
                        for (int n = 0; n < 2; ++n) rv[mm][bj][n] = *(const f32x4*)(xi + (size_t)(row0 + ai * 128 + (mp * 2 + mm) * 16) * DM + col0 + bj * 128 + n * 16);
#pragma unroll
                for (int mm = 0; mm < 2; ++mm)
#pragma unroll
                    for (int bj = 0; bj < 2; ++bj)
#pragma unroll
                        for (int n = 0; n < 2; ++n) *(f32x4*)(xo + (size_t)(row0 + ai * 128 + (mp * 2 + mm) * 16) * DM + col0 + bj * 128 + n * 16) = rv[mm][bj][n] + acc[ai][bj][mp * 2 + mm][n]; }
    }
};

DI void tr_item(const float* W, int N, int k0, int n0, bf16_t* dst, int Kp, LAS float* scr, int lane) {
    float wv[32];
#pragma unroll
    for (int i = 0; i < 32; ++i) { const int kk = 2 * i + (lane >> 5); wv[i] = W[(size_t)(k0 + kk) * N + n0 + (lane & 31)]; }
#pragma unroll
    for (int i = 0; i < 32; ++i) { const int kk = 2 * i + (lane >> 5); scr[kk * 33 + (lane & 31)] = wv[i]; }
    LDS_WAIT(); asm volatile("" ::: "memory");
    const int c = lane & 7;
#pragma unroll
    for (int j = 0; j < 4; ++j) { const int n = (lane >> 3) + 8 * j; const LAS float* s = scr + (8 * c) * 33 + n;
        u32x4 o; o.x = pk2(s[0 * 33], s[1 * 33]); o.y = pk2(s[2 * 33], s[3 * 33]); o.z = pk2(s[4 * 33], s[5 * 33]); o.w = pk2(s[6 * 33], s[7 * 33]);
        *(u32x4*)(dst + (size_t)n * Kp + k0 + 8 * c) = o; }
    LDS_WAIT(); asm volatile("" ::: "memory");
}

DI void s5_prep(const Args& a, int l, int g, LAS unsigned char* lds) {
    const int tid = ltid();
    LAS float* POWr = (LAS float*)lds;
    LAS float* POWi = POWr + 4224;
    LAS float* BBr = POWi + 4224;
    LAS float* BBi = BBr + 2048;
    LAS float* CCr = BBi + 2048;
    LAS float* CCi = CCr + 2048;
    LAS float* KK = CCi + 2048;
    const float *lam_re = a.in[7], *lam_im = a.in[8], *log_dt = a.in[9], *b_re = a.in[10], *b_im = a.in[11], *c_re = a.in[12], *c_im = a.in[13], *d_skip = a.in[14];
    if (tid < 128) {
        const int d = tid >> 6, p = tid & 63; const int idx = ((l * 2 + d) * NG + g) * NP + p;
        const float lr = lam_re[idx], li = lam_im[idx], dt = expf(log_dt[(l * 2 + d) * NG + g]);
        const double rev1 = (double)li * (double)dt * 0.15915494309189535;
        for (int k = 0; k <= 32; ++k) { double rv = rev1 * (double)k; rv -= rint(rv); const float rvf = (float)rv;
            const float e = expf((float)k * lr * dt), s = __builtin_amdgcn_sinf(rvf), c = __builtin_amdgcn_cosf(rvf);
            POWr[(d * 33 + k) * 64 + p] = e * c; POWi[(d * 33 + k) * 64 + p] = e * s; }
        double r1 = rev1; r1 -= rint(r1); double rh = rev1 * 0.5; rh -= rint(rh);
        const float em1 = expm1f(lr * dt), s1 = __builtin_amdgcn_sinf((float)r1), c1 = __builtin_amdgcn_cosf((float)r1), sh = __builtin_amdgcn_sinf((float)rh);
        const float cm1 = -2.f * sh * sh;
        const float nr = em1 * c1 + cm1, ni = (em1 + 1.f) * s1;
        const float den = lr * lr + li * li; const float cr = (nr * lr + ni * li) / den, ci = (ni * lr - nr * li) / den;
        for (int cp = 0; cp < 16; ++cp) { const float br = b_re[(size_t)idx * 16 + cp], bi = b_im[(size_t)idx * 16 + cp];
            BBr[(d * 64 + p) * 16 + cp] = cr * br - ci * bi; BBi[(d * 64 + p) * 16 + cp] = cr * bi + ci * br; }
    }
    for (int i = tid; i < 2048; i += NTHREADS) { const int d = i >> 10, c = (i >> 6) & 15, p = i & 63; const size_t cidx = ((size_t)((l * 2 + d) * NG + g) * 16 + c) * 64 + p; CCr[i] = c_re[cidx]; CCi[i] = c_im[cidx]; }
    __syncthreads();
    { const int d = tid >> 8, c = (tid >> 4) & 15, cp = tid & 15; const int lane = tid & 63, gbase = lane & 48;
      float bbr[64], bbi[64];
#pragma unroll
      for (int p = 0; p < 64; ++p) { bbr[p] = BBr[(d * 64 + p) * 16 + cp]; bbi[p] = BBi[(d * 64 + p) * 16 + cp]; }
      float ccr[4], cci[4];
#pragma unroll
      for (int q = 0; q < 4; ++q) { ccr[q] = CCr[(d * 16 + c) * 64 + cp * 4 + q]; cci[q] = CCi[(d * 16 + c) * 64 + cp * 4 + q]; }
      for (int k = 0; k < 32; ++k) { float zr[4], zi[4];
#pragma unroll
          for (int q = 0; q < 4; ++q) { const float pr = POWr[(d * 33 + k) * 64 + cp * 4 + q], pi = POWi[(d * 33 + k) * 64 + cp * 4 + q]; zr[q] = ccr[q] * pr - cci[q] * pi; zi[q] = ccr[q] * pi + cci[q] * pr; }
          float s = 0.f;
#pragma unroll
          for (int p = 0; p < 64; ++p) { const float ar = __shfl(zr[p & 3], gbase + (p >> 2)), ai = __shfl(zi[p & 3], gbase + (p >> 2)); s += ar * bbr[p] - ai * bbi[p]; }
          KK[(d * 32 + k) * 256 + c * 16 + cp] = s; } }
    __syncthreads();
    bf16_t* bty = (bf16_t*)(a.ws + WS_BTY + (size_t)l * SZ_BTY) + (size_t)g * 512 * KY;
    for (int ch = tid; ch < 512 * 96; ch += NTHREADS) { const int row = ch / 96, kk0 = (ch % 96) * 8, t = row >> 4, c = row & 15; float v[8];
        if (kk0 < 512) { const int s = kk0 >> 4, cp0 = kk0 & 15;
#pragma unroll
            for (int e = 0; e < 8; ++e) { const int cp = cp0 + e; float x;
                if (s < t) x = KK[(0 * 32 + (t - s)) * 256 + c * 16 + cp];
                else if (s > t) x = KK[(1 * 32 + (s - t)) * 256 + c * 16 + cp];
                else x = KK[c * 16 + cp] + KK[32 * 256 + c * 16 + cp] + (c == cp ? d_skip[l * WB + g * 16 + c] : 0.f);
                v[e] = x; } }
        else { const int d = kk0 < 640 ? 0 : 1, f = kk0 - 512 - d * 128, ri = f >> 6, p0 = f & 63, k = d ? (32 - t) : (t + 1);
#pragma unroll
            for (int e = 0; e < 8; ++e) { const int p = p0 + e; const float cr = CCr[(d * 16 + c) * 64 + p], ci = CCi[(d * 16 + c) * 64 + p], pr = POWr[(d * 33 + k) * 64 + p], pi = POWi[(d * 33 + k) * 64 + p];
                v[e] = ri ? -(cr * pi + ci * pr) : (cr * pr - ci * pi); } }
        *(u32x4*)(bty + (size_t)row * KY + kk0) = pack8(v); }
    bf16_t* bte = (bf16_t*)(a.ws + WS_BTE + (size_t)l * SZ_BTE) + (size_t)g * 256 * KE;
    for (int ch = tid; ch < 256 * 64; ch += NTHREADS) { const int row = ch >> 6, kk0 = (ch & 63) * 8, d = row >> 7, ri = (row >> 6) & 1, p = row & 63, s = kk0 >> 4, cp0 = kk0 & 15, k = d ? s : (31 - s);
        const float pr = POWr[(d * 33 + k) * 64 + p], pi = POWi[(d * 33 + k) * 64 + p]; float v[8];
#pragma unroll
        for (int e = 0; e < 8; ++e) { const float br = BBr[(d * 64 + p) * 16 + cp0 + e], bi = BBi[(d * 64 + p) * 16 + cp0 + e]; v[e] = ri ? (pr * bi + pi * br) : (pr * br - pi * bi); }
        *(u32x4*)(bte + (size_t)row * KE + kk0) = pack8(v); }
    __syncthreads();
}

struct TrTile { const float* W; bf16_t* dst; int N, Kp; };
DI bool tr_decode(const Args& a, int it, TrTile& t) {
    constexpr int T0 = 32 * 40, T1 = 16 * 4, T2 = 16 * 8, T3 = 16 * 8, T4 = 32 * 8, TL = T0 + T1 + T2 + T3 + T4;
    if (it >= DEPTH * TL) return false;
    const int l = it / TL; int r = it % TL;
    if (r < T0) { const int kb = r / 40, tt = r % 40, n0 = tt < 16 ? tt * 256 : 4128 + (tt - 16) * 256;
        t.W = a.in[2] + (size_t)l * DM * PROJ + (size_t)(kb * 64) * PROJ + n0; t.N = PROJ; t.Kp = DM; t.dst = (bf16_t*)(a.ws + WS_WIN + (size_t)l * SZ_WIN) + (size_t)(tt * 256) * DM + kb * 64; return true; } r -= T0;
    if (r < T1) { const int kb = r / 4, tt = r % 4; t.W = a.in[15] + (size_t)l * WB * WB + (size_t)(kb * 64) * WB + tt * 256; t.N = WB; t.Kp = WB; t.dst = (bf16_t*)(a.ws + WS_WGLU + (size_t)l * SZ_WGLU) + (size_t)(tt * 256) * WB + kb * 64; return true; } r -= T1;
    if (r < T2) { const int kb = r / 8, tt = r % 8; t.W = a.in[17] + (size_t)l * WA * DM + (size_t)(kb * 64) * DM + tt * 256; t.N = DM; t.Kp = 2048; t.dst = (bf16_t*)(a.ws + WS_WPA + (size_t)l * 2 * SZ_WPA) + (size_t)(tt * 256) * 2048 + kb * 64; return true; } r -= T2;
    if (r < T3) { const int kb = r / 8, tt = r % 8; t.W = a.in[18] + (size_t)l * WB * DM + (size_t)(kb * 64) * DM + tt * 256; t.N = DM; t.Kp = 2048; t.dst = (bf16_t*)(a.ws + WS_WPA + (size_t)l * 2 * SZ_WPA) + (size_t)(tt * 256) * 2048 + 1024 + kb * 64; return true; } r -= T3;
    { const int kb = r / 8, tt = r % 8; t.W = a.in[20] + (size_t)l * DM * DM + (size_t)(kb * 64) * DM + tt * 256; t.N = DM; t.Kp = DM; t.dst = (bf16_t*)(a.ws + WS_WOUT + (size_t)l * SZ_WOUT) + (size_t)(tt * 256) * DM + kb * 64; return true; }
}
DI void phase_prologue(const Args& a, LAS unsigned char* lds) {
    const int tid = ltid(), lane = tid & 63, wave = tid >> 6, G = gridDim.x;
    const bool s5_last = ((blockIdx.x >> 3) & 1) != 0;
    if (!s5_last) { for (int it = blockIdx.x; it < DEPTH * NG; it += G) s5_prep(a, it >> 6, it & 63, lds); }
    __syncthreads();
    { LAS float* scr = (LAS float*)(lds + wave * 8448); const int gw = blockIdx.x * NWAVES + wave, NGW = G * NWAVES;
      for (int it = gw; it < DEPTH * 32; it += NGW) { const int l = it >> 5, kb = it & 31;
          tr_item(a.in[2] + (size_t)l * DM * PROJ, PROJ, kb * 64, 4096, (bf16_t*)(a.ws + WS_WBA + (size_t)l * SZ_WBA), DM, scr, lane); } }
    __syncthreads();
    LAS float* T = (LAS float*)lds;
    TrTile cur; int it = blockIdx.x; bool have = tr_decode(a, it, cur);
    f32x4 v[8];
    if (have) {
#pragma unroll
        for (int i = 0; i < 8; ++i) v[i] = *(const f32x4*)(cur.W + (size_t)(wave * 8 + i) * cur.N + 4 * lane); }
    while (have) {
#pragma unroll
        for (int i = 0; i < 8; ++i) *(LAS f32x4*)(T + (wave * 8 + i) * 260 + 4 * (lane ^ wave)) = v[i];
        LBAR();
        TrTile nxt; const bool hn = tr_decode(a, it + G, nxt);
        if (hn) {
#pragma unroll
            for (int i = 0; i < 8; ++i) v[i] = *(const f32x4*)(nxt.W + (size_t)(wave * 8 + i) * nxt.N + 4 * lane); }
#pragma unroll
        for (int p = 0; p < 4; ++p) { const int task = tid + 512 * p, n = task >> 3, c = task & 7; const LAS float* sp = T + (8 * c) * 260 + 4 * ((n >> 2) ^ c) + (n & 3);
            u32x4 o; o.x = pk2(sp[0 * 260], sp[1 * 260]); o.y = pk2(sp[2 * 260], sp[3 * 260]); o.z = pk2(sp[4 * 260], sp[5 * 260]); o.w = pk2(sp[6 * 260], sp[7 * 260]);
            *(u32x4*)(cur.dst + (size_t)n * cur.Kp + 8 * c) = o; }
        LBAR();
        cur = nxt; have = hn; it += G;
    }
    if (s5_last) { __syncthreads(); for (int it2 = blockIdx.x; it2 < DEPTH * NG; it2 += G) s5_prep(a, it2 >> 6, it2 & 63, lds); }
}

DI void phase_norm(const Args& a, int l, LAS unsigned char* lds) {
    const int tid = ltid(), lane = tid & 63, wave = tid >> 6, G = gridDim.x;
    const float* xin = l == 0 ? a.in[0] : (const float*)(a.ws + WS_X);
    const float* lng = a.in[1] + (size_t)l * DM;
    bf16_t* H = (bf16_t*)(a.ws + WS_H);
    const bf16_t* wba = (const bf16_t*)(a.ws + WS_WBA + (size_t)l * SZ_WBA);
    float* BA = (float*)(a.ws + WS_BA);
    for (int rg = blockIdx.x; rg < MTOK / 32; rg += G) {
        for (int rr = 0; rr < 4; ++rr) { const int row = rg * 32 + wave * 4 + rr;
            const f32x4* xr = (const f32x4*)(xin + (size_t)row * DM) + lane; f32x4 v[8]; float s = 0.f;
#pragma unroll
            for (int j = 0; j < 8; ++j) { v[j] = xr[64 * j]; s += (v[j].x * v[j].x + v[j].y * v[j].y) + (v[j].z * v[j].z + v[j].w * v[j].w); }
            const float rstd = rsqrtf(wave_sum(s) * (1.f / DM) + RMS_EPS);
            u32x2* o8 = (u32x2*)(H + (size_t)row * DM) + lane;
#pragma unroll
            for (int j = 0; j < 8; ++j) { const f32x4 gg = ((const f32x4*)lng)[lane + 64 * j]; u32x2 w; w.x = pk2(v[j].x * rstd * gg.x, v[j].y * rstd * gg.y); w.y = pk2(v[j].z * rstd * gg.z, v[j].w * rstd * gg.w); o8[64 * j] = w; }
        }
        __syncthreads();
        { const int r = lane & 31, hh = lane >> 5; f32x16 acc;
#pragma unroll
          for (int i = 0; i < 16; ++i) acc[i] = 0.f;
          const bf16_t* ap = H + (size_t)(rg * 32 + r) * DM + wave * 256 + 8 * hh; const bf16_t* bp = wba + (size_t)r * DM + wave * 256 + 8 * hh;
#pragma unroll 4
          for (int i = 0; i < 16; ++i) { const bf16x8 af = *(const bf16x8*)(ap + 16 * i), bfr = *(const bf16x8*)(bp + 16 * i); acc = MFMA32(af, bfr, acc); }
          LAS float* red = (LAS float*)lds + wave * 1024;
#pragma unroll
          for (int i = 0; i < 16; ++i) red[crow(i, hh) * 32 + r] = acc[i];
        }
        __syncthreads();
        for (int o = tid; o < 1024; o += NTHREADS) { float s = 0.f;
#pragma unroll
            for (int w = 0; w < 8; ++w) s += ((LAS float*)lds)[w * 1024 + o];
            BA[(size_t)(rg * 32 + (o >> 5)) * 32 + (o & 31)] = s; }
        __syncthreads();
    }
}

DI bf16_t* rec_ptr(const Args& a, int b, int h, int dir, int j) { return (bf16_t*)(a.ws + WS_REC + (size_t)(((b * NH + h) * 2 + dir) * 32 + j) * REC_BYTES); }
constexpr int REC_W = 0, REC_U = 8192, REC_QG = 16384, REC_KDT = 24576, REC_QK = 32768;


template <int DIR>
DI void solve_T(const LAS float* LM, const LAS float* SM, LAS unsigned short* AMv, LAS unsigned short* AMw, int cp) {
    const LAS float* Lm = LM + DIR * 4096;
    const int c = DIR ? 63 - cp : cp; const float sv = SM[DIR * 64 + c], sw = sv * SM[256 + DIR * 64 + c];
    LAS unsigned short* ov = AMv + c; LAS unsigned short* ow = AMw + c;
    typedef float f32x2p __attribute__((ext_vector_type(2)));
    f32x2p xs[32];
#pragma unroll
    for (int q = 0; q < 32; ++q) xs[q] = (f32x2p){0.f, 0.f};
    f32x4 cur[16], nxt[16];
#pragma unroll
    for (int q = 0; q < 16; ++q) { cur[q] = (f32x4){0.f, 0.f, 0.f, 0.f}; nxt[q] = (f32x4){0.f, 0.f, 0.f, 0.f}; }
#pragma unroll
    for (int rp = 0; rp < 64; ++rp) { const int r = DIR ? 63 - rp : rp;
        asm volatile("" ::: "memory");
        if (rp + 1 < 64) {
#pragma unroll
            for (int s4 = 0; s4 < (rp + 1 + 3) / 4; ++s4) nxt[s4] = *(const LAS f32x4*)(Lm + (rp + 1) * 64 + 4 * s4); }
        float bv = (rp == cp) ? 1.f : 0.f;
        f32x2p pa[2] = {(f32x2p){0.f, 0.f}, (f32x2p){0.f, 0.f}}, pb[2] = {(f32x2p){0.f, 0.f}, (f32x2p){0.f, 0.f}};
#pragma unroll
        for (int s4 = 0; s4 < (rp + 3) / 4; ++s4) { const f32x2p la = (f32x2p){cur[s4].x, cur[s4].y}, lb = (f32x2p){cur[s4].z, cur[s4].w};
            pa[s4 & 1] += la * xs[2 * s4]; pb[s4 & 1] += lb * xs[2 * s4 + 1]; }
        const f32x2p pt = (pa[0] + pa[1]) + (pb[0] + pb[1]);
        bv -= pt.x + pt.y;
        if (rp & 1) xs[rp >> 1].y = bv; else xs[rp >> 1].x = bv;
        ov[r * 72] = (unsigned short)(pk2(bv * sv, 0.f) & 0xffffu); ow[r * 72] = (unsigned short)(pk2(bv * sw, 0.f) & 0xffffu);
#pragma unroll
        for (int q = 0; q < 16; ++q) cur[q] = nxt[q]; }
}

DI void prep_unit(const Args& a, int l, int pu, LAS unsigned char* lds) {
    const int tid = ltid(), lane = tid & 63, wave = tid >> 6;
    asm volatile("" : "+s"(pu));
    const int h = pu & 7, j = (pu >> 3) & 31, b = pu >> 8;
    constexpr int RAW_PITCH = 784;
    LAS unsigned char* RAW = lds;
    LAS float* LM = (LAS float*)lds;
    LAS unsigned short* AM = (LAS unsigned short*)(lds + 33856);
    LAS unsigned short* KB = (LAS unsigned short*)(lds + 53312);
    LAS unsigned short* QB = (LAS unsigned short*)(lds + 70720);
    LAS unsigned short* VT = (LAS unsigned short*)(lds + 88128);
    LAS unsigned short* KT = (LAS unsigned short*)(lds + 106560);
    LAS float* SM = (LAS float*)(lds + 124992);
    const bf16_t* pq = (const bf16_t*)(a.ws + WS_PQKV);
    for (int ci = tid; ci < 68 * 48; ci += NTHREADS) { const int rr = ci / 48, rem = ci % 48, tn = rem >> 4, c16 = rem & 15; const int tok = j * 64 - 2 + rr;
        u32x4 v = (u32x4){0u, 0u, 0u, 0u};
        if (tok >= 0 && tok < SEQ) v = *(const u32x4*)(pq + (size_t)(b * SEQ + tok) * 3072 + tn * 1024 + h * 128 + c16 * 8);
        *(LAS u32x4*)(RAW + rr * RAW_PITCH + tn * 256 + c16 * 16) = v; }
    LBAR();
    if (tid < 384) { const int tn = tid >> 7, rb = (tid & 127) >> 3, cs = tid & 7, r0 = rb * 4; const float* cw = a.in[3] + (size_t)l * 5 * 3072 + tn * 1024 + h * 128 + cs * 16;
        f32x4 w[5][4];
#pragma unroll
        for (int i = 0; i < 5; ++i) { const f32x4* wp = (const f32x4*)(cw + (size_t)i * 3072); w[i][0] = wp[0]; w[i][1] = wp[1]; w[i][2] = wp[2]; w[i][3] = wp[3]; }
        float acc[4][16];
#pragma unroll
        for (int jj = 0; jj < 4; ++jj)
#pragma unroll
            for (int c = 0; c < 16; ++c) acc[jj][c] = 0.f;
#pragma unroll
        for (int rr = 0; rr < 8; ++rr) { const LAS u32x4* xp = (const LAS u32x4*)(RAW + (r0 + rr) * RAW_PITCH + tn * 256 + cs * 32); float x[16]; { float x0[8], x1[8]; unpack8(xp[0], x0); unpack8(xp[1], x1);
#pragma unroll
              for (int c = 0; c < 8; ++c) { x[c] = x0[c]; x[8 + c] = x1[c]; } }
#pragma unroll
            for (int jj = 0; jj < 4; ++jj) { const int i = rr - jj; if (i >= 0 && i < 5) {
#pragma unroll
                for (int c = 0; c < 16; ++c) acc[jj][c] += x[c] * w[i][c >> 2][c & 3]; } } }
        float rs[4];
#pragma unroll
        for (int jj = 0; jj < 4; ++jj) { float ss = 0.f;
#pragma unroll
            for (int c = 0; c < 16; ++c) { acc[jj][c] = siluf_(acc[jj][c]); ss += acc[jj][c] * acc[jj][c]; }
            ss += __shfl_xor(ss, 1); ss += __shfl_xor(ss, 2); ss += __shfl_xor(ss, 4);
            rs[jj] = tn == 2 ? 1.f : rsqrtf(ss + RMS_EPS) * (tn == 0 ? 0.08838834764831845f : 1.0f);
#pragma unroll
            for (int c = 0; c < 16; ++c) acc[jj][c] *= rs[jj];
            if (tn < 2) { LAS unsigned short* dst = (tn == 0 ? QB : KB) + (r0 + jj) * 136 + cs * 16;
#pragma unroll
                for (int c = 0; c < 16; c += 2) *(LAS unsigned*)(dst + c) = pk2(acc[jj][c], acc[jj][c + 1]); } }
        if (tn >= 1) { LAS unsigned short* tp = (tn == 1 ? KT : VT) + (cs * 16) * 72 + r0;
#pragma unroll
            for (int c = 0; c < 16; ++c) { u32x2 wv; wv.x = pk2(acc[0][c], acc[1][c]); wv.y = pk2(acc[2][c], acc[3][c]); *(LAS u32x2*)(tp + c * 72) = wv; } } }
    if (wave == 7) {
        const int tok = b * SEQ + j * 64 + lane; const float* ba = (const float*)(a.ws + WS_BA) + (size_t)tok * 32;
        const float blf = ba[h], blb = ba[8 + h], alf = ba[16 + h], alb = ba[24 + h];
        const float af = expf(a.in[4][(l * 2 + 0) * NH + h]), ab = expf(a.in[4][(l * 2 + 1) * NH + h]);
        const float xf = alf + a.in[5][(l * 2 + 0) * NH + h], xb = alb + a.in[5][(l * 2 + 1) * NH + h];
        const float spf = xf > 20.f ? xf : log1pf(expf(xf)), spb = xb > 20.f ? xb : log1pf(expf(xb));
        const float gf = -af * spf, gb = -ab * spb;
        float pf = gf, pb = gb;
#pragma unroll
        for (int o = 1; o < 64; o <<= 1) { const float tf = __shfl_up(pf, o), tb = __shfl_up(pb, o); if (lane >= o) { pf += tf; pb += tb; } }
        const float totb = __shfl(pb, 63); const float gcb = totb - pb + gb;
        SM[lane] = sigmoidf_(blf); SM[64 + lane] = sigmoidf_(blb); SM[128 + lane] = pf; SM[192 + lane] = gcb; SM[256 + lane] = expf(pf); SM[320 + lane] = expf(gcb); }
    LBAR();
    bf16_t* rec[2] = {rec_ptr(a, b, h, 0, j), rec_ptr(a, b, h, 1, j)};
    { const int mat = wave >> 2, mb = wave & 1, nb = (wave >> 1) & 1, r = lane & 31, hh = lane >> 5; f32x16 acc;
#pragma unroll
      for (int i = 0; i < 16; ++i) acc[i] = 0.f;
      const LAS unsigned short* Ap = (mat ? QB : KB) + (32 * mb + r) * 136 + 8 * hh; const LAS unsigned short* Bp = KB + (32 * nb + r) * 136 + 8 * hh;
#pragma unroll
      for (int ks = 0; ks < 8; ++ks) { const bf16x8 af = *(const LAS bf16x8*)(Ap + 16 * ks), bfr = *(const LAS bf16x8*)(Bp + 16 * ks); acc = MFMA32(af, bfr, acc); }
      const int s = 32 * nb + r; const float gcf_s = SM[128 + s], gcb_s = SM[192 + s];
#pragma unroll
      for (int i = 0; i < 16; ++i) { const int c = 32 * mb + crow(i, hh); const float df = SM[128 + c] - gcf_s, db = SM[192 + c] - gcb_s;
          const float ef = __expf(fminf(df, 0.f)), eb = __expf(fminf(db, 0.f));
          if (mat == 0) { LM[c * 64 + s] = (c > s) ? SM[c] * acc[i] * ef : 0.f; LM[4096 + (63 - c) * 64 + (63 - s)] = (c < s) ? SM[64 + c] * acc[i] * eb : 0.f; }
          else { rec[0][REC_QK + c * 64 + s] = (bf16_t)(pk2((c >= s) ? acc[i] * ef : 0.f, 0.f) & 0xffffu); rec[1][REC_QK + c * 64 + s] = (bf16_t)(pk2((c <= s) ? acc[i] * eb : 0.f, 0.f) & 0xffffu); } } }
    LBAR();
    if (wave == 0) solve_T<0>(LM, SM, AM, AM + 4608, lane);
    else if (wave == 1) solve_T<1>(LM, SM, AM + 9216, AM + 13824, lane);
    else {
        for (int it = tid - 128; it < 512; it += 384) { const int r = it >> 3, cs = it & 7; const float ef = SM[256 + r], eb = SM[320 + r]; float o[8];
            const LAS u32x4* qp = (const LAS u32x4*)(QB + r * 136 + cs * 16); float q0[8], q1[8]; unpack8(qp[0], q0); unpack8(qp[1], q1);
#pragma unroll
            for (int d = 0; d < 2; ++d) { const float e = d ? eb : ef;
#pragma unroll
                for (int c = 0; c < 8; ++c) o[c] = q0[c] * e;
                *(u32x4*)(rec[d] + REC_QG + r * 128 + cs * 16) = pack8(o);
#pragma unroll
                for (int c = 0; c < 8; ++c) o[c] = q1[c] * e;
                *(u32x4*)(rec[d] + REC_QG + r * 128 + cs * 16 + 8) = pack8(o); } }
        const float glf = SM[128 + 63], glb = SM[192 + 0];
        for (int it = tid - 128; it < 512; it += 384) { const int dd = it >> 2, cq = it & 3; float k0[8], k1[8];
            const LAS u32x4* kp = (const LAS u32x4*)(KT + dd * 72 + cq * 16); unpack8(kp[0], k0); unpack8(kp[1], k1);
#pragma unroll
            for (int d = 0; d < 2; ++d) { float o[8];
#pragma unroll
                for (int i = 0; i < 8; ++i) { const int c = cq * 16 + i; o[i] = k0[i] * (d ? __expf(glb - SM[192 + c]) : __expf(glf - SM[128 + c])); }
                *(u32x4*)(rec[d] + REC_KDT + dd * 64 + cq * 16) = pack8(o);
#pragma unroll
                for (int i = 0; i < 8; ++i) { const int c = cq * 16 + 8 + i; o[i] = k1[i] * (d ? __expf(glb - SM[192 + c]) : __expf(glf - SM[128 + c])); }
                *(u32x4*)(rec[d] + REC_KDT + dd * 64 + cq * 16 + 8) = pack8(o); } }
        if (tid == 128) { float* eg = (float*)(a.ws + WS_EGP); eg[(size_t)(((b * NH + h) * 2 + 0) * 32 + j) * 32] = __expf(glf); eg[(size_t)(((b * NH + h) * 2 + 1) * 32 + j) * 32] = __expf(glb); }
    }
    LBAR();
    { const int p = wave >> 1, mb = wave & 1, r = lane & 31, hh = lane >> 5;
      const LAS unsigned short* Ap = AM + p * 4608 + (32 * mb + r) * 72 + 8 * hh; const LAS unsigned short* Bt = (p & 1) ? KT : VT;
      bf16x8 af[4];
#pragma unroll
      for (int ks = 0; ks < 4; ++ks) af[ks] = *(const LAS bf16x8*)(Ap + 16 * ks);
      bf16_t* outp = rec[p >> 1] + ((p & 1) ? REC_W : REC_U) + (32 * mb) * 128 + r;
#pragma unroll
      for (int nbk = 0; nbk < 4; ++nbk) { f32x16 acc;
#pragma unroll
          for (int i = 0; i < 16; ++i) acc[i] = 0.f;
          const LAS unsigned short* Bp = Bt + (32 * nbk + r) * 72 + 8 * hh;
#pragma unroll
          for (int ks = 0; ks < 4; ++ks) { const bf16x8 bfr = *(const LAS bf16x8*)(Bp + 16 * ks); acc = MFMA32(af[ks], bfr, acc); }
#pragma unroll
          for (int i = 0; i < 16; ++i) outp[crow(i, hh) * 128 + 32 * nbk] = (bf16_t)(pk2(acc[i], 0.f) & 0xffffu); } }
    LBAR();
}

DI void scan_unit(const Args& a, int su, LAS unsigned char* lds) {
    const int tid = ltid(), lane = tid & 63, wave = tid >> 6, r = lane & 31, hh = lane >> 5;
    const int vs = su & 1, dir = (su >> 1) & 1, h = (su >> 2) & 7, b = su >> 5;
    LAS unsigned char* Lw = lds;
    LAS unsigned char* Lqg = lds + 17408;
    LAS unsigned char* Lkd0 = lds + 34816;
    LAS unsigned char* Lqk0 = lds + 71680;
    LAS unsigned char* Lu = lds + 90112;
    LAS unsigned char* LS = lds + 99328;
    LAS unsigned char* LV = lds + 116736;
    const float* EG = (const float*)(a.ws + WS_EGP) + (size_t)(((b * NH + h) * 2 + dir) * 32) * 32;
    const float egv = EG[(lane & 31) * 32];
    float* O = (float*)(a.ws + WS_OF) + (size_t)dir * MTOK * 1024;
    for (int i = tid; i < 17408 / 4; i += NTHREADS) ((LAS unsigned*)LS)[i] = 0u;
    f32x16 Sacc;
#pragma unroll
    for (int i = 0; i < 16; ++i) Sacc[i] = 0.f;
    u32x4 preA[8], preB[8];
#define SCAN_PREFETCH(pre, jx) do { const unsigned char* rb = (const unsigned char*)rec_ptr(a, b, h, dir, (jx)); \
        _Pragma("unroll") for (int i = 0; i < 2; ++i) { const int ci = tid + 512 * i; pre[i] = *(const u32x4*)(rb + REC_W * 2 + (ci >> 4) * 256 + (ci & 15) * 16); pre[2 + i] = *(const u32x4*)(rb + REC_QG * 2 + (ci >> 4) * 256 + (ci & 15) * 16); \
            pre[4 + i] = *(const u32x4*)(rb + REC_KDT * 2 + (ci >> 3) * 128 + (ci & 7) * 16); } \
        pre[6] = *(const u32x4*)(rb + REC_QK * 2 + (tid >> 3) * 128 + (tid & 7) * 16); \
        pre[7] = *(const u32x4*)(rb + REC_U * 2 + (tid >> 3) * 256 + vs * 128 + (tid & 7) * 16); } while (0)
    SCAN_PREFETCH(preA, dir ? 31 : 0);
    SCAN_PREFETCH(preB, dir ? 30 : 1);
    const int mb = wave & 1, nb = (wave >> 1) & 1, kb = wave & 3, nb2 = wave >> 2;
#define SCAN_STEP(pre, step) do { const int j = dir ? 31 - (step) : (step); LAS unsigned char* Lkd = Lkd0 + ((step) & 1) * 18432; LAS unsigned char* Lqk = Lqk0 + ((step) & 1) * 9216; \
        _Pragma("unroll") for (int i = 0; i < 2; ++i) { const int ci = tid + 512 * i; *(LAS u32x4*)(Lw + (ci >> 4) * 272 + (ci & 15) * 16) = pre[i]; *(LAS u32x4*)(Lqg + (ci >> 4) * 272 + (ci & 15) * 16) = pre[2 + i]; \
            *(LAS u32x4*)(Lkd + (ci >> 3) * 144 + (ci & 7) * 16) = pre[4 + i]; } \
        *(LAS u32x4*)(Lqk + (tid >> 3) * 144 + (tid & 7) * 16) = pre[6]; \
        *(LAS u32x4*)(Lu + (tid >> 3) * 144 + (tid & 7) * 16) = pre[7]; \
        LBAR(); \
        if ((step) + 2 < 32) SCAN_PREFETCH(pre, dir ? 29 - (step) : (step) + 2); \
        const float eg = __shfl(egv, j); \
        f32x16 acc; \
        _Pragma("unroll") for (int i = 0; i < 16; ++i) acc[i] = 0.f; \
        { const LAS unsigned char* Ap = (wave < 4 ? Lw : Lqg) + (32 * mb + r) * 272 + 16 * hh; const LAS unsigned char* Bp = LS + (32 * nb + r) * 272 + 16 * hh; \
          _Pragma("unroll") for (int ks = 0; ks < 8; ++ks) { const bf16x8 af = *(const LAS bf16x8*)(Ap + 32 * ks), bfr = *(const LAS bf16x8*)(Bp + 32 * ks); acc = MFMA32(af, bfr, acc); } } \
        if (wave < 4) { \
            _Pragma("unroll") for (int g4 = 0; g4 < 4; ++g4) { float vn[4]; \
                _Pragma("unroll") for (int jj = 0; jj < 4; ++jj) { const int row = 32 * mb + 8 * g4 + 4 * hh + jj; vn[jj] = bf2f(*(const LAS unsigned short*)(Lu + row * 144 + (32 * nb + r) * 2)) - acc[4 * g4 + jj]; } \
                u32x2 w; w.x = pk2(vn[0], vn[1]); w.y = pk2(vn[2], vn[3]); \
                *(LAS u32x2*)(LV + (32 * nb + r) * 144 + (32 * mb + 8 * g4 + 4 * hh) * 2) = w; } } \
        LBAR(); \
        if (wave >= 4) { \
            const LAS unsigned char* Ap = Lqk + (32 * mb + r) * 144 + 16 * hh; const LAS unsigned char* Bp = LV + (32 * nb + r) * 144 + 16 * hh; \
            _Pragma("unroll") for (int ks = 0; ks < 4; ++ks) { const bf16x8 af = *(const LAS bf16x8*)(Ap + 32 * ks), bfr = *(const LAS bf16x8*)(Bp + 32 * ks); acc = MFMA32(af, bfr, acc); } \
            float* op = O + (size_t)(b * SEQ + j * 64 + 32 * mb) * 1024 + h * 128 + vs * 64 + 32 * nb + r; \
            _Pragma("unroll") for (int i = 0; i < 16; ++i) op[(size_t)crow(i, hh) * 1024] = acc[i]; \
        } \
        { \
            _Pragma("unroll") for (int i = 0; i < 16; ++i) Sacc[i] *= eg; \
            const LAS unsigned char* Ap = Lkd + (32 * kb + r) * 144 + 16 * hh; const LAS unsigned char* Bp = LV + (32 * nb2 + r) * 144 + 16 * hh; \
            _Pragma("unroll") for (int ks = 0; ks < 4; ++ks) { const bf16x8 af = *(const LAS bf16x8*)(Ap + 32 * ks), bfr = *(const LAS bf16x8*)(Bp + 32 * ks); Sacc = MFMA32(af, bfr, Sacc); } \
        } \
        _Pragma("unroll") for (int g4 = 0; g4 < 4; ++g4) { u32x2 w; w.x = pk2(Sacc[4 * g4], Sacc[4 * g4 + 1]); w.y = pk2(Sacc[4 * g4 + 2], Sacc[4 * g4 + 3]); \
            *(LAS u32x2*)(LS + (32 * nb2 + r) * 272 + (32 * kb + 8 * g4 + 4 * hh) * 2) = w; } \
    } while (0)
    for (int step = 0; step < 32; step += 2) { SCAN_STEP(preA, step); SCAN_STEP(preB, step + 1); }
#undef SCAN_STEP
#undef SCAN_PREFETCH
    __syncthreads();
}

DI void s5_carry(const Args& a, int l, int g) {
    const int tid = ltid(), bq = tid >> 7, dir = (tid >> 6) & 1, p = tid & 63;
    const int idx = ((l * 2 + dir) * NG + g) * NP + p;
    const float lr = a.in[7][idx], li = a.in[8][idx], dt = expf(a.in[9][(l * 2 + dir) * NG + g]);
    double rv = (double)li * (double)dt * 0.15915494309189535 * 32.0; rv -= rint(rv);
    const float e = expf(32.f * lr * dt), Tr = e * __builtin_amdgcn_cosf((float)rv), Ti = e * __builtin_amdgcn_sinf((float)rv);
    const float* E = (const float*)(a.ws + WS_EBUF) + (size_t)g * 256 * 256 + dir * 128 + p;
    bf16_t* A = (bf16_t*)(a.ws + WS_AS5) + (size_t)g * 256 * KY + 512 + dir * 128 + p;
    float cr = 0.f, ci = 0.f;
    for (int j0 = 0; j0 < 64; j0 += 16) { float er[16], ei[16];
#pragma unroll
        for (int k = 0; k < 16; ++k) { const int n = bq * 64 + (dir ? 63 - (j0 + k) : (j0 + k)); er[k] = E[(size_t)n * 256]; ei[k] = E[(size_t)n * 256 + 64]; }
#pragma unroll
        for (int k = 0; k < 16; ++k) { const int n = bq * 64 + (dir ? 63 - (j0 + k) : (j0 + k));
            A[(size_t)n * KY] = (bf16_t)(pk2(cr, 0.f) & 0xffffu); A[(size_t)n * KY + 64] = (bf16_t)(pk2(ci, 0.f) & 0xffffu);
            const float nr = Tr * cr - Ti * ci + er[k], ni = Tr * ci + Ti * cr + ei[k]; cr = nr; ci = ni; } }
    __syncthreads();
}

DI void post_a_rows2(const Args& a, int l, int tok0, int tok1, int lane) {
    const float* hg = a.in[6] + (size_t)l * HD + (lane & 7) * 16;
    f32x4 xf[2][4], xb[2][4]; u32x4 zz[2][2];
#pragma unroll
    for (int t = 0; t < 2; ++t) { const int tok = t ? tok1 : tok0;
        const float* of = (const float*)(a.ws + WS_OF) + (size_t)tok * 1024 + lane * 16; const float* ob = of + (size_t)MTOK * 1024;
        const u32x4* zp = (const u32x4*)((const bf16_t*)(a.ws + WS_ZA) + (size_t)tok * 1024 + lane * 16);
#pragma unroll
        for (int c = 0; c < 4; ++c) { xf[t][c] = ((const f32x4*)of)[c]; xb[t][c] = ((const f32x4*)ob)[c]; }
        zz[t][0] = zp[0]; zz[t][1] = zp[1]; }
#pragma unroll
    for (int t = 0; t < 2; ++t) { const int tok = t ? tok1 : tok0;
        float o[16]; float ss = 0.f;
#pragma unroll
        for (int c = 0; c < 4; ++c) { const f32x4 x = xf[t][c] + xb[t][c]; o[4 * c] = x.x; o[4 * c + 1] = x.y; o[4 * c + 2] = x.z; o[4 * c + 3] = x.w; ss += (x.x * x.x + x.y * x.y) + (x.z * x.z + x.w * x.w); }
        ss += __shfl_xor(ss, 1); ss += __shfl_xor(ss, 2); ss += __shfl_xor(ss, 4);
        const float rs = rsqrtf(ss * (1.f / HD) + RMS_EPS);
        float z0[8], z1[8]; unpack8(zz[t][0], z0); unpack8(zz[t][1], z1);
        float r0[8], r1[8];
#pragma unroll
        for (int c = 0; c < 8; ++c) { r0[c] = o[c] * rs * hg[c] * siluf_(z0[c]); r1[c] = o[8 + c] * rs * hg[8 + c] * siluf_(z1[c]); }
        u32x4* dp = (u32x4*)((bf16_t*)(a.ws + WS_AA) + (size_t)tok * 2048 + lane * 16); dp[0] = pack8(r0); dp[1] = pack8(r1); }
}

DI void final_row(const Args& a, int row, int lane) {
    const f32x4* xr = (const f32x4*)((const float*)(a.ws + WS_X) + (size_t)row * DM) + lane; f32x4 v[8]; float s = 0.f;
#pragma unroll
    for (int j = 0; j < 8; ++j) { v[j] = xr[64 * j]; s += (v[j].x * v[j].x + v[j].y * v[j].y) + (v[j].z * v[j].z + v[j].w * v[j].w); }
    const float rstd = rsqrtf(wave_sum(s) * (1.f / DM) + RMS_EPS);
    f32x4* o = (f32x4*)(a.out + (size_t)row * DM) + lane;
#pragma unroll
    for (int j = 0; j < 8; ++j) { const f32x4 gg = ((const f32x4*)a.in[21])[lane + 64 * j]; o[64 * j] = v[j] * rstd * gg; }
}


#define XB_TMO      128
#define XB_XCNT(j)  (256  + 64 * (j))
#define XB_XSUB(j)  (1280 + 64 * (j))
#define XB_XGEN(j)  (2304 + 64 * (j))
#define XB_TOP      3328
#define XB_TOPGEN   3392
#define XCD_BAR_WORDS 3456
#define XB_SPIN_CAP (1u << 22)
DI unsigned xb_ld(unsigned* p)              { return __hip_atomic_load(p, __ATOMIC_RELAXED, __HIP_MEMORY_SCOPE_AGENT); }
DI unsigned xb_add(unsigned* p, unsigned v) { return __hip_atomic_fetch_add(p, v, __ATOMIC_RELAXED, __HIP_MEMORY_SCOPE_AGENT); }
DI unsigned xb_xcc_id() { return (unsigned)__builtin_amdgcn_s_getreg((3 << 11) | 20) & 0xFu; }
#define XB_SPIN(cond, bar) do { unsigned _sp = 0; while (cond) { __builtin_amdgcn_s_sleep(1); \
    if ((++_sp & 255u) == 0u) { if (xb_ld(&(bar)[XB_TMO])) break; if (_sp > XB_SPIN_CAP) { atomicAdd(&(bar)[XB_TMO], 1u); break; } } } } while (0)
struct XcdBarrier { unsigned* bar; unsigned x; volatile LAS unsigned* st; };
DI XcdBarrier xcd_barrier_post(unsigned* bar, volatile LAS unsigned* st) {
    XcdBarrier b; b.bar = bar; b.x = xb_xcc_id(); b.st = st;
    if (__builtin_amdgcn_workitem_id_x() == 0) (void)xb_add(&bar[XB_XCNT(b.x)], 1u);
    return b;
}
DI void xcd_barrier_complete(unsigned* bar, unsigned x, unsigned& nloc, unsigned& nx) {
    const unsigned G = gridDim.x * gridDim.y * gridDim.z;
    unsigned sum, cnt, mine, sp = 0u;
    for (;;) {
        sum = 0u; cnt = 0u; mine = 0u;
#pragma unroll
        for (unsigned j = 0; j < 16; ++j) { const unsigned c = xb_ld(&bar[XB_XCNT(j)]); sum += c; cnt += (c > 0u) ? 1u : 0u; mine = (j == x) ? c : mine; }
        if (sum == G) break;
        __builtin_amdgcn_s_sleep(1);
        if ((++sp & 255u) == 0u) { if (xb_ld(&bar[XB_TMO])) break; if (sp > XB_SPIN_CAP) { atomicAdd(&bar[XB_TMO], 1u); break; } }
    }
    nloc = mine > 0u ? mine : 1u; nx = cnt > 0u ? cnt : 1u;
}
DI void xcd_barrier(const XcdBarrier& b) {
    asm volatile("s_waitcnt vmcnt(0)" ::: "memory");
    __syncthreads();
    if (__builtin_amdgcn_workitem_id_x() == 0) {
        unsigned* bar = b.bar;
        __builtin_amdgcn_s_waitcnt(0);
        unsigned nloc = b.st[0], nx = b.st[1];
        if (nloc == 0u) { xcd_barrier_complete(bar, b.x, nloc, nx); b.st[0] = nloc; b.st[1] = nx; }
        const unsigned old = xb_add(&bar[XB_XSUB(b.x)], 1u);
        const unsigned gen = old / nloc;
        if (old + 1u == (gen + 1u) * nloc) {
            __builtin_amdgcn_fence(__ATOMIC_RELEASE, "agent");
            asm volatile("s_waitcnt vmcnt(0)" ::: "memory");
            const unsigned og = xb_add(&bar[XB_TOP], 1u);
            const unsigned tg = og / nx;
            if (og + 1u == (tg + 1u) * nx) xb_add(&bar[XB_TOPGEN], 1u);
            else XB_SPIN(xb_ld(&bar[XB_TOPGEN]) == tg, bar);
            __builtin_amdgcn_fence(__ATOMIC_ACQUIRE, "agent");
            xb_add(&bar[XB_XGEN(b.x)], 1u);
            asm volatile("s_waitcnt vmcnt(0)" ::: "memory");
        } else {
            XB_SPIN(xb_ld(&bar[XB_XGEN(b.x)]) == gen, bar);
            __builtin_amdgcn_fence(__ATOMIC_ACQUIRE, "agent");
            asm volatile("s_waitcnt vmcnt(0)" ::: "memory");
        }
    }
    __syncthreads();
}

constexpr int NPHASE = 2 + 7 * DEPTH;
__global__ void __launch_bounds__(NTHREADS, 2) mega(Args a) {
    extern __shared__ __attribute__((aligned(16))) unsigned char lds_raw[];
    LAS unsigned char* lds = (LAS unsigned char*)lds_raw;
    const int G = gridDim.x, bid = blockIdx.x;
#if !MULTI_LAUNCH
    volatile LAS unsigned* bst = (volatile LAS unsigned*)(lds + LDS_BYTES - 64);
    if (__builtin_amdgcn_workitem_id_x() == 0) { bst[0] = 0u; bst[1] = 0u; }
    __syncthreads();
    (void)xcd_barrier_post((unsigned*)(a.ws + WS_CTL) + 1024, bst);
#endif
    for (int ph = a.lo; ph < a.hi; ++ph) {
        {
        const int tid = ltid(), lane = tid & 63, wave = tid >> 6;
        unsigned char* ws = a.ws; asm volatile("" : "+s"(ws));
        if (ph == 0) { if (PM & 1) phase_prologue(a, lds); }
        else if (ph == NPHASE - 1) { if (PM & 2) for (int row = bid * NWAVES + wave; row < MTOK; row += G * NWAVES) final_row(a, row, lane); }
        else {
            const int l = (ph - 1) / 7, k = (ph - 1) % 7;
            if (k == 0) { if (PM & 4) phase_norm(a, l, lds); }
            else if (k == 1) { if (PM & 8) {
                pg8::Gemm g{(const bf16_t*)(ws + WS_H), (const bf16_t*)(ws + WS_WIN + (size_t)l * SZ_WIN), DM, DM, DM}; pg8::StaticOrder S; S.init(MTOK, NMAIN, G, bid);
                EpiInProj E{(bf16_t*)(ws + WS_PQKV), (bf16_t*)(ws + WS_ZA), (bf16_t*)(ws + WS_AS5), (bf16_t*)(ws + WS_ZB), (bf16_t*)(ws + WS_GT), a.in[19] + (size_t)l * 4096};
                pg8::gemm_phase(lds, g, S, E);
            } } else if (k == 2) {
                if (PM & 32) {
                for (int pu = bid; pu < NB * 32 * NH; pu += G) prep_unit(a, l, pu, lds); }
            } else if (k == 3) {
                const int half = G / 2;
                if (bid < half) { if (PM & 64) for (int su = bid; su < 128; su += half) scan_unit(a, su, lds); }
                else { for (int yu = bid - half; yu < 128; yu += G - half) {
                        { pg8::Gemm g{(const bf16_t*)(ws + WS_AS5), (const bf16_t*)(ws + WS_BTE + (size_t)l * SZ_BTE), KY, KE, KE}; pg8::ListOrder S{yu >> 1, 1 << 30, NG, 0}; EpiE E{(float*)(ws + WS_EBUF)};
                          pg8::gemm_phase(lds, g, S, E); }
                        __syncthreads();
                        s5_carry(a, l, yu >> 1);
                        pg8::Gemm g{(const bf16_t*)(ws + WS_AS5), (const bf16_t*)(ws + WS_BTY + (size_t)l * SZ_BTY), KY, KY, KY}; pg8::ListOrder S{yu, 1 << 30, 128, 1}; EpiY E{(bf16_t*)(ws + WS_YS)};
                        pg8::gemm_phase(lds, g, S, E); __syncthreads(); } }
            } else if (k == 4) {
                if (PM & 256) { pg8::Gemm g{(const bf16_t*)(ws + WS_YS), (const bf16_t*)(ws + WS_WGLU + (size_t)l * SZ_WGLU), WB, WB, WB}; pg8::StaticOrder S; S.init(MTOK, WB, G, bid);
                  EpiGlu E{(const bf16_t*)(ws + WS_YS), (const bf16_t*)(ws + WS_ZB), a.in[16] + (size_t)l * WB, (bf16_t*)(ws + WS_AA)};
                  pg8::gemm_phase(lds, g, S, E); }
                if (PM & 512) {
                const int nglu = (MTOK / 256) * (WB / 256);
                if (G > nglu) { if (bid >= nglu) { const int st = (G - nglu) * NWAVES; for (int row = (bid - nglu) * NWAVES + wave; row < MTOK; row += 2 * st) post_a_rows2(a, l, row, (row + st < MTOK) ? row + st : row, lane); } }
                else { const int st = G * NWAVES; for (int row = bid * NWAVES + wave; row < MTOK; row += 2 * st) post_a_rows2(a, l, row, (row + st < MTOK) ? row + st : row, lane); } }
            } else if (k == 5) { if (PM & 1024) {
                pg8::StaticOrder S; S.init(MTOK, DM, G, bid);
                pg8::Gemm g{(const bf16_t*)(ws + WS_AA), (const bf16_t*)(ws + WS_WPA + (size_t)l * 2 * SZ_WPA), DM, DM, DM}; EpiMergeF E{(const bf16_t*)(ws + WS_GT), (bf16_t*)(ws + WS_MG)}; pg8::gemm_phase(lds, g, S, E);
            } } else { if (PM & 2048) {
                pg8::Gemm g{(const bf16_t*)(ws + WS_MG), (const bf16_t*)(ws + WS_WOUT + (size_t)l * SZ_WOUT), DM, DM, DM}; pg8::StaticOrder S; S.init(MTOK, DM, G, bid);
                EpiOut E{l == 0 ? a.in[0] : (const float*)(ws + WS_X), (float*)(ws + WS_X)};
                pg8::gemm_phase(lds, g, S, E);
            } }
        }
        __syncthreads(); }
#if !MULTI_LAUNCH
        if (ph + 1 < a.hi) { if (ph == a.lo) cg::this_grid().sync(); else { unsigned char* wsb = a.ws; asm volatile("" : "+s"(wsb)); XcdBarrier xb; xb.bar = (unsigned*)(wsb + WS_CTL) + 1024; xb.x = xb_xcc_id(); xb.st = (volatile LAS unsigned*)(lds + LDS_BYTES - 64); xcd_barrier(xb); } }
#endif
    }
}


extern "C" void kernel_launch(void* const* d_in, const int* in_sizes, int n_in, void* d_out, int out_size, void* d_ws, size_t ws_size, hipStream_t stream) {
    static int grid = 0;
    if (grid == 0) {
        int dev = 0, cus = 0, per_cu = 0;
        hipGetDevice(&dev); hipDeviceGetAttribute(&cus, hipDeviceAttributeMultiprocessorCount, dev);
        hipFuncSetAttribute((const void*)mega, hipFuncAttributeMaxDynamicSharedMemorySize, LDS_BYTES);
        hipOccupancyMaxActiveBlocksPerMultiprocessor(&per_cu, (const void*)mega, NTHREADS, LDS_BYTES);
        if (per_cu < 1) { fprintf(stderr, "kernel_launch: occupancy query says %d blocks/CU\n", per_cu); per_cu = 1; }
        grid = cus;
        if (ws_size < WS_END) fprintf(stderr, "kernel_launch: workspace too small: %zu < %zu\n", ws_size, (size_t)WS_END);
        (void)hipGetLastError();
    }
    hipMemsetAsync((char*)d_ws + WS_CTL, 0, 32768, stream);
    Args a{};
    for (int i = 0; i < 22; ++i) a.in[i] = (const float*)d_in[i];
    a.out = (float*)d_out; a.ws = (unsigned char*)d_ws;
#if MULTI_LAUNCH
    for (int ph = 0; ph < NPHASE; ++ph) { a.lo = ph; a.hi = ph + 1; hipLaunchKernelGGL(mega, dim3(grid), dim3(NTHREADS), LDS_BYTES, stream, a); }

#else
    a.lo = 0; a.hi = NPHASE;
    void* args[] = {&a};
    hipError_t e = hipLaunchCooperativeKernel((const void*)mega, dim3(grid), dim3(NTHREADS), args, LDS_BYTES, stream);
    if (e != hipSuccess) fprintf(stderr, "cooperative launch failed: %s (grid %d)\n", hipGetErrorString(e), grid);
#endif
}
```
